# Optimizing an MI355X kernel written in HIP

```python
import jax, jax.numpy as jnp
from jax import lax
import numpy as np

D_MODEL = 1024
BATCH = 16
SEQ = 2048
DEPTH = 1

MIX_A = D_MODEL // 2
MIX_B = D_MODEL - MIX_A
CHUNK = 128
A_GROUPS = 4
A_GROUP_DIM = MIX_A // A_GROUPS
B_HEAD_DIM = 64
B_HEADS = MIX_B // B_HEAD_DIM
LORA_W = 64
LORA_A = 64
LORA_G = 160
RWKV_COLS = 3 * MIX_B + LORA_W + LORA_A + LORA_G
IN_COLS = 2 * MIX_A + RWKV_COLS
FFN_HIDDEN = ((8 * D_MODEL + 3 * 256 - 1) // (3 * 256)) * 256
ALPHA = (2 * DEPTH) ** 0.25
BETA = (8 * DEPTH) ** -0.25
LN_EPS = 1e-5
GN_EPS = 64e-5

kernel_name = "hybrid_gmlp_rwkv7_deepnorm_adaln"


def layer_norm(x, g, b, eps=LN_EPS):
    xf = x.astype(jnp.float32)
    mu = jnp.mean(xf, axis=-1, keepdims=True)
    var = jnp.mean(jnp.square(xf - mu), axis=-1, keepdims=True)
    y = (xf - mu) * lax.rsqrt(var + eps)
    return (y * g.astype(jnp.float32) + b.astype(jnp.float32)).astype(x.dtype)


def token_shift(p):
    return jnp.pad(p, ((0, 0), (1, 0), (0, 0)))[:, :-1]


def gmlp_spatial_gating(pu, pv, ln_g, ln_b, w_s, b_s):
    B, S, _ = pu.shape
    nc = S // CHUNK
    u = jax.nn.gelu(pu)
    v = layer_norm(jax.nn.gelu(pv), ln_g, ln_b)
    vc = v.reshape(B, nc, CHUNK, A_GROUPS, A_GROUP_DIM)
    mask = jnp.tril(jnp.ones((CHUNK, CHUNK), dtype=w_s.dtype))
    s = jnp.einsum('gts,bnsgd->bntgd', w_s * mask, vc) + b_s.T[None, None, :, :, None]
    return u * s.reshape(B, S, MIX_A)


def _rwkv7_step(S, inp):
    r, w, k, v, a, b = inp
    sa = jnp.einsum('bhij,bhj->bhi', S, a)
    S = S * w[:, :, None, :] + sa[..., None] * b[:, :, None, :] + v[..., None] * k[:, :, None, :]
    y = jnp.einsum('bhij,bhj->bhi', S, r)
    return S, y


def rwkv7_time_mix(p, mu, w0, w_up, a0, a_up, g_up, k_k, k_a, r_k, lnx_g, lnx_b):
    B, S, _ = p.shape
    p = p + (token_shift(p) - p) * mu
    r, k, v = p[..., :MIX_B], p[..., MIX_B:2 * MIX_B], p[..., 2 * MIX_B:3 * MIX_B]
    o = 3 * MIX_B
    wd = p[..., o:o + LORA_W]
    ad = p[..., o + LORA_W:o + LORA_W + LORA_A]
    gd = p[..., o + LORA_W + LORA_A:]
    f32 = jnp.float32
    wlog = -jax.nn.softplus(-(w0 + jnp.tanh(wd) @ w_up).astype(f32)) - 0.5
    decay = jnp.exp(-jnp.exp(wlog))
    a = jax.nn.sigmoid((a0 + ad @ a_up).astype(f32))
    g = jax.nn.sigmoid(gd) @ g_up
    rf, kf, vf = r.astype(f32), k.astype(f32), v.astype(f32)
    heads = lambda t: t.reshape(B, S, B_HEADS, B_HEAD_DIM)
    kk = heads(kf * k_k.astype(f32))
    kk = kk / jnp.maximum(jnp.sqrt(jnp.sum(kk * kk, axis=-1, keepdims=True)), 1e-12)
    kf = kf * (1.0 + (a - 1.0) * k_a.astype(f32))
    rh, kh, vh, wh, ah = heads(rf), heads(kf), heads(vf), heads(decay), heads(a)
    xs = tuple(jnp.swapaxes(t, 0, 1) for t in (rh, wh, kh, vh, -kk, kk * ah))
    S0 = jnp.zeros((B, B_HEADS, B_HEAD_DIM, B_HEAD_DIM), f32)
    _, y = lax.scan(_rwkv7_step, S0, xs)
    y = jnp.swapaxes(y, 0, 1)
    mu_y = jnp.mean(y, axis=-1, keepdims=True)
    var_y = jnp.mean(jnp.square(y - mu_y), axis=-1, keepdims=True)
    y = ((y - mu_y) * lax.rsqrt(var_y + GN_EPS)).reshape(B, S, MIX_B)
    y = y * lnx_g.astype(f32) + lnx_b.astype(f32)
    bonus = jnp.sum(rh * kh * r_k.astype(f32), axis=-1, keepdims=True) * vh
    y = y + bonus.reshape(B, S, MIX_B)
    return (y * g.astype(f32)).astype(p.dtype)


def setup_inputs(seed: int = 0) -> dict:
    key = jax.random.key(seed)
    ks = jax.random.split(key, 32)
    L, D = DEPTH, D_MODEL
    f32 = jnp.float32
    nrm = lambda k, shape, s: jax.random.normal(k, shape, f32) * s
    return {
        "x": nrm(ks[0], (BATCH, SEQ, D), 1.0),
        "c": nrm(ks[1], (BATCH, D), 1.0),
        "emb_ln_g": 1.0 + nrm(ks[2], (D,), 0.05),
        "emb_ln_b": nrm(ks[3], (D,), 0.02),
        "w_ada": nrm(ks[4], (L, D, 6 * D), 0.5 * D ** -0.5),
        "b_ada": nrm(ks[5], (L, 6 * D), 0.02),
        "w_in": nrm(ks[6], (L, D, IN_COLS), D ** -0.5),
        "mu_shift": jax.random.uniform(ks[7], (L, RWKV_COLS), f32),
        "sg_ln_g": 1.0 + nrm(ks[8], (L, MIX_A), 0.05),
        "sg_ln_b": nrm(ks[9], (L, MIX_A), 0.02),
        "w_s": nrm(ks[10], (L, A_GROUPS, CHUNK, CHUNK), CHUNK ** -0.5),
        "b_s": 1.0 + nrm(ks[11], (L, A_GROUPS, CHUNK), 0.1),
        "w0": jax.random.uniform(ks[12], (L, MIX_B), f32, -6.0, 1.0),
        "w_up": nrm(ks[13], (L, LORA_W, MIX_B), LORA_W ** -0.5),
        "a0": nrm(ks[14], (L, MIX_B), 0.1),
        "a_up": nrm(ks[15], (L, LORA_A, MIX_B), LORA_A ** -0.5),
        "g_up": nrm(ks[16], (L, LORA_G, MIX_B), LORA_G ** -0.5),
        "k_k": 0.85 + nrm(ks[17], (L, MIX_B), 0.05),
        "k_a": 1.0 + nrm(ks[18], (L, MIX_B), 0.05),
        "r_k": nrm(ks[19], (L, B_HEADS, B_HEAD_DIM), 0.1),
        "lnx_g": 1.0 + nrm(ks[20], (L, MIX_B), 0.05),
        "lnx_b": nrm(ks[21], (L, MIX_B), 0.02),
        "w_out": nrm(ks[22], (L, D, D), BETA * D ** -0.5),
        "ln1_g": 1.0 + nrm(ks[23], (L, D), 0.05),
        "ln1_b": nrm(ks[24], (L, D), 0.02),
        "w_ffn_in": nrm(ks[25], (L, D, 2 * FFN_HIDDEN), D ** -0.5),
        "w_ffn_out": nrm(ks[26], (L, FFN_HIDDEN, D), BETA * FFN_HIDDEN ** -0.5),
        "ln2_g": 1.0 + nrm(ks[27], (L, D), 0.05),
        "ln2_b": nrm(ks[28], (L, D), 0.02),
    }


def reference(x, c, emb_ln_g, emb_ln_b, w_ada, b_ada, w_in, mu_shift, sg_ln_g, sg_ln_b, w_s, b_s,
              w0, w_up, a0, a_up, g_up, k_k, k_a, r_k, lnx_g, lnx_b, w_out, ln1_g, ln1_b,
              w_ffn_in, w_ffn_out, ln2_g, ln2_b):
    x = layer_norm(x, emb_ln_g, emb_ln_b)
    cs = jax.nn.silu(c)
    for l in range(DEPTH):
        mod = cs @ w_ada[l] + b_ada[l]
        sh1, sc1, gt1, sh2, sc2, gt2 = [m[:, None, :] for m in jnp.split(mod, 6, axis=-1)]
        h = x * (1.0 + sc1) + sh1
        p = h @ w_in[l]
        y_a = gmlp_spatial_gating(p[..., :MIX_A], p[..., MIX_A:2 * MIX_A],
                                  sg_ln_g[l], sg_ln_b[l], w_s[l], b_s[l])
        y_b = rwkv7_time_mix(p[..., 2 * MIX_A:], mu_shift[l], w0[l], w_up[l], a0[l], a_up[l],
                             g_up[l], k_k[l], k_a[l], r_k[l], lnx_g[l], lnx_b[l])
        mix = jnp.concatenate([y_a, y_b], axis=-1) @ w_out[l]
        x = layer_norm(ALPHA * x + gt1 * mix, ln1_g[l], ln1_b[l])
        h = x * (1.0 + sc2) + sh2
        gu = h @ w_ffn_in[l]
        f = (jax.nn.silu(gu[..., :FFN_HIDDEN]) * gu[..., FFN_HIDDEN:]) @ w_ffn_out[l]
        x = layer_norm(ALPHA * x + gt2 * f, ln2_g[l], ln2_b[l])
    return x
```

```cpp
#include <hip/hip_runtime.h>
#include <hip/hip_cooperative_groups.h>
#include <cstdio>
#include <cstdint>
namespace cg = cooperative_groups;
namespace pg8 {
#define PG8_LAS __attribute__((address_space(3)))
typedef unsigned short bf16_t;
typedef short bf16x8 __attribute__((ext_vector_type(8)));
typedef float f32x4 __attribute__((ext_vector_type(4)));
typedef unsigned u32x4 __attribute__((ext_vector_type(4)));
constexpr int BM = 256, BK = 64, HALF = 128, HTB = HALF * BK * 2  , STAGE_BYTES = 8 * HTB, NXCD = 8, WGM = 8;

__host__ __device__ __forceinline__ int lds_byte(int r, int c) { const int st = (r >> 4) * 2 + (c >> 5), rr = r & 15, cc = c & 31, ob = rr * 64 + cc * 2; return st * 1024 + (ob ^ (((ob >> 9) & 1) << 5)); }
__host__ __device__ __forceinline__ void stage_rc(int b, int& R, int& C) { const int st = b / 1024, sb = b % 1024, swz = sb ^ (((sb >> 9) & 1) << 5); R = (st >> 1) * 16 + swz / 64; C = (st & 1) * 32 + (swz % 64) / 2; }
__host__ __device__ __forceinline__ int perm32(int rho) { const int n = rho >> 4, i = rho & 15; return 8 * (i >> 2) + 4 * n + (i & 3); }

struct Unit { int pm, pn; };
struct Gemm { const bf16_t* A; const bf16_t* Bt; int M, N, K; };

struct StaticOrder {
    int nM, nN, nwg, G, c;
    __host__ __device__ void init(int M, int N, int G_, int c_) { nM = M / BM; nN = N / BM; nwg = nM * nN; G = G_; c = c_; }
    __host__ __device__ bool next(int i, Unit& u) const {
        const long L = (long)i * G + c; if (L >= nwg) return false;
        int wgid = (int)L; { const int q = nwg / NXCD, r = nwg % NXCD, xcd = wgid % NXCD, off = wgid / NXCD; wgid = (xcd < r ? xcd * (q + 1) : r * (q + 1) + (xcd - r) * q) + off; }
        const int nig = WGM * nN, gid = wgid / nig, fm = gid * WGM, gsz = (nM - fm) < WGM ? (nM - fm) : WGM;
        u.pm = fm + ((wgid % nig) % gsz); u.pn = (wgid % nig) / gsz; return true;
    }
    __device__ __forceinline__ void a_ready(const Unit&) const {}
    __device__ __forceinline__ void done(const Unit&) const {}
};

__device__ __forceinline__ unsigned cvt_pk_bf16(float lo, float hi) { unsigned r; asm volatile("v_cvt_pk_bf16_f32 %0, %1, %2" : "=v"(r) : "v"(lo), "v"(hi)); return r; }
typedef float f32x2 __attribute__((ext_vector_type(2)));
__device__ __forceinline__ f32x2 gelu_pk(f32x2 v) {
    const f32x2 av = __builtin_elementwise_abs(v), d = av * 0.2316418882f + 1.0f;
    f32x2 t; t.x = __builtin_amdgcn_rcpf(d.x); t.y = __builtin_amdgcn_rcpf(d.y);
    f32x2 q = t * 0.5307027145f + (-0.7265760135f); q = q * t + 0.7107068705f; q = q * t + (-0.142248368f); q = q * t + 0.127414796f; q = q * t;
    const f32x2 s = (v * v) * (-0.72134752044f);
    f32x2 e; e.x = __builtin_amdgcn_exp2f(s.x); e.y = __builtin_amdgcn_exp2f(s.y);
    const f32x2 m = v * (q * e), r = v - m;
    f32x2 o; o.x = v.x < 0.f ? m.x : r.x; o.y = v.y < 0.f ? m.y : r.y; return o;
}

template <int ACT  > struct EpiBf16 {
    static constexpr bool PERM = true, AFTER_DRAIN = false; static_assert(ACT == 0 || ACT == 1, "EpiBf16: ACT is 0 (none) or 1 (gelu_pk)");
    bf16_t* O; int ldc; const float* bias; int split_cols; size_t split_stride; float scale0;
    __device__ __forceinline__ void operator()(const f32x4 (&acc)[2][2][4][2], const Unit& u, int wr, int wc, int fr, int fq) const {
        const int row0 = u.pm * BM + wr * 64 + fr; int colt = u.pn * BM; bf16_t* base = O;
        float sc = 1.f; if (split_cols) { const int t = colt / split_cols; base += (size_t)t * split_stride; colt -= t * split_cols; if (t == 0) sc = scale0; }
        const int col0 = colt + wc * 32 + 8 * fq, bcol0 = u.pn * BM + wc * 32 + 8 * fq;
        f32x4 bv[2][2];
#pragma unroll
        for (int bj = 0; bj < 2; ++bj)
#pragma unroll
            for (int n = 0; n < 2; ++n) bv[bj][n] = bias ? *(const f32x4*)(bias + bcol0 + bj * HALF + 4 * n) : (f32x4){0.f, 0.f, 0.f, 0.f};
#pragma unroll
        for (int ai = 0; ai < 2; ++ai)
#pragma unroll
            for (int m = 0; m < 4; ++m) { bf16_t* rowp = base + (size_t)(row0 + ai * HALF + m * 16) * ldc + col0;
#pragma unroll
                for (int bj = 0; bj < 2; ++bj) { f32x4 v0 = acc[ai][bj][m][0] + bv[bj][0], v1 = acc[ai][bj][m][1] + bv[bj][1];
                    if (ACT == 1) { f32x2 a = gelu_pk((f32x2){v0[0], v0[1]}), b = gelu_pk((f32x2){v0[2], v0[3]}), c = gelu_pk((f32x2){v1[0], v1[1]}), d = gelu_pk((f32x2){v1[2], v1[3]});
                        v0 = (f32x4){a.x, a.y, b.x, b.y}; v1 = (f32x4){c.x, c.y, d.x, d.y}; }
                    v0 = v0 * sc; v1 = v1 * sc; u32x4 w; w.x = cvt_pk_bf16(v0[0], v0[1]); w.y = cvt_pk_bf16(v0[2], v0[3]); w.z = cvt_pk_bf16(v1[0], v1[1]); w.w = cvt_pk_bf16(v1[2], v1[3]);
                    *(u32x4*)(rowp + bj * HALF) = w; } }
    }
};

struct PanelStats {
    unsigned* xbuf;
    unsigned* cnt;
    unsigned* tmo;
    int ntn; float eps;
    unsigned code;
    __device__ __forceinline__ bool run(const f32x4 (&v)[2][2][4][2], const Unit& u, int wr, int wc, int fr, int fq, PG8_LAS unsigned char* lds, int wid, int lane) const {
        typedef float f32x2v __attribute__((ext_vector_type(2)));
        PG8_LAS f32x2v* P = (PG8_LAS f32x2v*)lds;
        PG8_LAS f32x2v* S = (PG8_LAS f32x2v*)(lds + 8192);
        PG8_LAS unsigned* flag = (PG8_LAS unsigned*)(lds + 8192 + 2048);
#pragma unroll
        for (int ai = 0; ai < 2; ++ai)
#pragma unroll
            for (int m = 0; m < 4; ++m) {
                float s = 0.f;
#pragma unroll
                for (int bj = 0; bj < 2; ++bj)
#pragma unroll
                    for (int n = 0; n < 2; ++n) { const f32x4 x = v[ai][bj][m][n]; s += (x[0] + x[1]) + (x[2] + x[3]); }
                s += __shfl_xor(s, 16); s += __shfl_xor(s, 32);
                const float mw = s * (1.0f / 64.0f); float q = 0.f;
#pragma unroll
                for (int bj = 0; bj < 2; ++bj)
#pragma unroll
                    for (int n = 0; n < 2; ++n) { const f32x4 d = v[ai][bj][m][n] - mw; q += (d[0] * d[0] + d[1] * d[1]) + (d[2] * d[2] + d[3] * d[3]); }
                q += __shfl_xor(q, 16); q += __shfl_xor(q, 32);
                if (fq == 0) P[(ai * HALF + wr * 64 + m * 16 + fr) * 4 + wc] = (f32x2v){mw, q};
            }
        asm volatile("s_waitcnt lgkmcnt(0)" ::: "memory"); __builtin_amdgcn_s_barrier(); asm volatile("" ::: "memory");
#if defined(BROKEN_EXCHANGE_NO_WAIT)
#warning BROKEN CONTROL BUILD: the row-statistics exchange does not wait; results are wrong by design
        if (blockIdx.x >= 64) { const long long t0_ = clock64(); while (clock64() - t0_ < 60000) __builtin_amdgcn_s_sleep(8); }
#endif
        const int row = wid * 32 + (lane & 31);
        if (lane < 32) {
            const f32x2v a = P[row * 4 + 0], b = P[row * 4 + 1], c = P[row * 4 + 2], d = P[row * 4 + 3];
            const float mt = (a.x + b.x + c.x + d.x) * 0.25f;
            const float da = a.x - mt, db = b.x - mt, dc = c.x - mt, dd = d.x - mt;
            const float m2 = (a.y + b.y) + (c.y + d.y) + 64.0f * ((da * da + db * db) + (dc * dc + dd * dd));
            unsigned long long* slot = (unsigned long long*)xbuf + ((size_t)(u.pm * BM + row) * 4 + u.pn);
            __hip_atomic_store(slot, ((unsigned long long)__float_as_uint(m2) << 32) | __float_as_uint(mt), __ATOMIC_RELAXED, __HIP_MEMORY_SCOPE_AGENT);
        }
        asm volatile("s_waitcnt vmcnt(0)" ::: "memory");
        if (lane == 0) __hip_atomic_fetch_add(cnt + 64 * u.pm, 1u, __ATOMIC_RELAXED, __HIP_MEMORY_SCOPE_AGENT);
        if (wid == 0) {
            bool dead = false; const unsigned long long t0 = __builtin_amdgcn_s_memrealtime(); const unsigned want = 8u * (unsigned)ntn;
            for (;;) {
#if defined(BROKEN_EXCHANGE_NO_WAIT)
                break;
#endif
                if ((unsigned)__builtin_amdgcn_readfirstlane(__hip_atomic_load(cnt + 64 * u.pm, __ATOMIC_RELAXED, __HIP_MEMORY_SCOPE_AGENT)) >= want) break;
                if (__builtin_amdgcn_s_memrealtime() - t0 > 2000000ull) {
                    if (lane == 0) { unsigned expect = 0u; __hip_atomic_compare_exchange_strong(tmo + 1, &expect, code | (unsigned)(u.pm & 0xff), __ATOMIC_RELAXED, __ATOMIC_RELAXED, __HIP_MEMORY_SCOPE_AGENT);
                                     __hip_atomic_store(tmo, 1u, __ATOMIC_RELAXED, __HIP_MEMORY_SCOPE_AGENT); }
                    dead = true; break; }
                __builtin_amdgcn_s_sleep(2);
            }
            __builtin_amdgcn_fence(__ATOMIC_ACQUIRE, "agent");
            if (lane == 0) flag[0] = dead ? 1u : 0u;
        }
        asm volatile("s_waitcnt vmcnt(0) lgkmcnt(0)" ::: "memory"); __builtin_amdgcn_s_barrier(); asm volatile("" ::: "memory");
        const bool bad = flag[0] != 0u;
        if (lane < 32) {
            const unsigned long long* slot = (const unsigned long long*)xbuf + (size_t)(u.pm * BM + row) * 4; float mt[4], m2[4]; float ms = 0.f;
#pragma unroll
            for (int t = 0; t < 4; ++t) { if (t < ntn) { const unsigned long long w = __hip_atomic_load(slot + t, __ATOMIC_RELAXED, __HIP_MEMORY_SCOPE_AGENT); mt[t] = __uint_as_float((unsigned)w); m2[t] = __uint_as_float((unsigned)(w >> 32)); } else { mt[t] = 0.f; m2[t] = 0.f; } ms += mt[t]; }
            const float mean = ms / (float)ntn; float q = 0.f;
#pragma unroll
            for (int t = 0; t < 4; ++t) if (t < ntn) { const float dm = mt[t] - mean; q += m2[t] + 256.0f * dm * dm; }
            S[row] = (f32x2v){mean, 1.0f / sqrtf(q / (256.0f * (float)ntn) + eps)};
        }
        asm volatile("s_waitcnt lgkmcnt(0)" ::: "memory"); __builtin_amdgcn_s_barrier(); asm volatile("" ::: "memory");
        return bad;
    }
};
struct EpiLnRes {
    static constexpr bool PERM = false, AFTER_DRAIN = true;
    const float* base; float* out; int ldc; const float* bias; PanelStats st; unsigned poison;
    __device__ __forceinline__ void fused(f32x4 (&acc)[2][2][4][2], const Unit& u, int wr, int wc, int fr, int fq, PG8_LAS unsigned char* lds, int wid, int lane) const {
        typedef float f32x2v __attribute__((ext_vector_type(2)));
        const PG8_LAS f32x2v* S = (const PG8_LAS f32x2v*)(lds + 8192);
        const int col0 = u.pn * BM + wc * 32 + 4 * fq;
#pragma unroll
        for (int bj = 0; bj < 2; ++bj)
#pragma unroll
            for (int n = 0; n < 2; ++n) { const f32x4 bv = bias ? *(const f32x4*)(bias + col0 + bj * HALF + n * 16) : (f32x4){0.f, 0.f, 0.f, 0.f};
#pragma unroll
                for (int ai = 0; ai < 2; ++ai)
#pragma unroll
                    for (int m = 0; m < 4; ++m) acc[ai][bj][m][n] += bv; }
        f32x4 pre[4][2][2];
#pragma unroll
        for (int m = 0; m < 4; ++m) { const size_t off = (size_t)(u.pm * BM + wr * 64 + m * 16 + fr) * ldc + col0;
#pragma unroll
            for (int bj = 0; bj < 2; ++bj)
#pragma unroll
                for (int n = 0; n < 2; ++n) pre[m][bj][n] = *(const f32x4*)(base + off + bj * HALF + n * 16); }
        const bool bad = st.run(acc, u, wr, wc, fr, fq, lds, wid, lane) || poison != 0u;
        const float qnan = __builtin_nanf("");
#pragma unroll
        for (int ai = 0; ai < 2; ++ai)
#pragma unroll
            for (int m = 0; m < 4; ++m) { const int r = ai * HALF + wr * 64 + m * 16 + fr; const f32x2v sr = S[r]; const size_t off = (size_t)(u.pm * BM + r) * ldc + col0;
#pragma unroll
                for (int bj = 0; bj < 2; ++bj)
#pragma unroll
                    for (int n = 0; n < 2; ++n) { const f32x4 bs = ai == 0 ? pre[m][bj][n] : *(const f32x4*)(base + off + bj * HALF + n * 16); f32x4 o = bs + (acc[ai][bj][m][n] - sr.x) * sr.y;
                        if (bad) o = (f32x4){qnan, qnan, qnan, qnan}; *(f32x4*)(out + off + bj * HALF + n * 16) = o; }
                if (m & 1) asm volatile("" ::: "memory"); }
    }
};
struct EpiLnResLn {
    static constexpr bool PERM = false, AFTER_DRAIN = true;
    const float* base; float* out; bf16_t* xn; int ldc; const float* bias; PanelStats st1, st2; unsigned poison;
    __device__ __forceinline__ void fused(f32x4 (&acc)[2][2][4][2], const Unit& u, int wr, int wc, int fr, int fq, PG8_LAS unsigned char* lds, int wid, int lane) const {
        typedef float f32x2v __attribute__((ext_vector_type(2))); typedef unsigned u32x2v __attribute__((ext_vector_type(2)));
        const PG8_LAS f32x2v* S = (const PG8_LAS f32x2v*)(lds + 8192);
        const int col0 = u.pn * BM + wc * 32 + 4 * fq;
#pragma unroll
        for (int bj = 0; bj < 2; ++bj)
#pragma unroll
            for (int n = 0; n < 2; ++n) { const f32x4 bv = bias ? *(const f32x4*)(bias + col0 + bj * HALF + n * 16) : (f32x4){0.f, 0.f, 0.f, 0.f};
#pragma unroll
                for (int ai = 0; ai < 2; ++ai)
#pragma unroll
                    for (int m = 0; m < 4; ++m) acc[ai][bj][m][n] += bv; }
        bool bad = st1.run(acc, u, wr, wc, fr, fq, lds, wid, lane) || poison != 0u;
        const float qnan = __builtin_nanf("");
#pragma unroll
        for (int ai = 0; ai < 2; ++ai)
#pragma unroll
            for (int m = 0; m < 4; ++m) { const int r = ai * HALF + wr * 64 + m * 16 + fr; const f32x2v sr = S[r]; const size_t off = (size_t)(u.pm * BM + r) * ldc + col0;
#pragma unroll
                for (int bj = 0; bj < 2; ++bj)
#pragma unroll
                    for (int n = 0; n < 2; ++n) { const f32x4 bs = *(const f32x4*)(base + off + bj * HALF + n * 16); acc[ai][bj][m][n] = bs + (acc[ai][bj][m][n] - sr.x) * sr.y; }
                asm volatile("" : "+v"(acc[ai][0][m][0]), "+v"(acc[ai][0][m][1]), "+v"(acc[ai][1][m][0]), "+v"(acc[ai][1][m][1]));
                if (m & 1) asm volatile("" ::: "memory"); }
        const bool bad1 = bad;
        bad = st2.run(acc, u, wr, wc, fr, fq, lds, wid, lane) || bad;
#pragma unroll
        for (int ai = 0; ai < 2; ++ai)
#pragma unroll
            for (int m = 0; m < 4; ++m) { const int r = ai * HALF + wr * 64 + m * 16 + fr; const f32x2v sr = S[r]; const size_t off = (size_t)(u.pm * BM + r) * ldc + col0;
#pragma unroll
                for (int bj = 0; bj < 2; ++bj)
#pragma unroll
                    for (int n = 0; n < 2; ++n) { const f32x4 x1 = acc[ai][bj][m][n]; *(f32x4*)(out + off + bj * HALF + n * 16) = bad1 ? (f32x4){qnan, qnan, qnan, qnan} : x1;
                        const f32x4 o = (x1 - sr.x) * sr.y; u32x2v w; w.x = cvt_pk_bf16(o[0], o[1]); w.y = cvt_pk_bf16(o[2], o[3]);
                        if (bad) { w.x = 0x7fc07fc0u; w.y = 0x7fc07fc0u; } *(u32x2v*)(xn + off + bj * HALF + n * 16) = w; }
                asm volatile("" ::: "memory"); }
    }
};

template <class Epi, class Sched, bool ALIGN_EPI = false, bool SP2 = false>
__device__ __forceinline__ void gemm_phase(PG8_LAS unsigned char* lds, const Gemm g, const Sched& S, const Epi& E) {
    const int tid = threadIdx.x, wid = __builtin_amdgcn_readfirstlane(tid >> 6), lane = tid & 63, wr = wid >> 2, wc = wid & 3, fr = lane & 15, fq = lane >> 4;
    const int K = g.K, nt = K / BK;
    unsigned voffA[2], voffB[2];
#pragma unroll
    for (int i = 0; i < 2; ++i) { int R, C; stage_rc(tid * 16 + i * 8192, R, C); const int Rb = Epi::PERM ? ((R & ~31) + perm32(R & 31)) : R;
        voffA[i] = (unsigned)(R * K + C) * 2u; voffB[i] = (unsigned)(Rb * K + C) * 2u; }
    const size_t kstep = (size_t)(BK * 2);
    const size_t hstep = (size_t)HALF * K * 2;
    const size_t tstep = 2 * hstep;
    const unsigned ldsw = (unsigned)wid * 1024u;
    const int aoff = lds_byte(wr * 64 + fr, fq * 8), boff = lds_byte(wc * 32 + fr, fq * 8);
#define PG8_SA(b, h) (((b) * 2 + (h)) * HTB)
#define PG8_SB(b, h) ((4 + (b) * 2 + (h)) * HTB)
#define PG8_STAGE(bufoff, gbase, voff) do { _Pragma("unroll") for (int _i = 0; _i < 2; ++_i) \
        __builtin_amdgcn_global_load_lds((const unsigned*)((const char*)(gbase) + (voff)[_i]), (PG8_LAS unsigned*)(lds + (bufoff) + ldsw + _i * 8192), 16, 0, 0); } while (0)
#define PG8_LDA(dst, b, h) do { _Pragma("unroll") for (int m = 0; m < 4; ++m) _Pragma("unroll") for (int k = 0; k < 2; ++k) dst[m][k] = *(const PG8_LAS bf16x8*)(lds + PG8_SA(b, h) + aoff + m * 2048 + k * 1024); } while (0)
#define PG8_LDB(dst, b, h) do { _Pragma("unroll") for (int n = 0; n < 2; ++n) _Pragma("unroll") for (int k = 0; k < 2; ++k) dst[n][k] = *(const PG8_LAS bf16x8*)(lds + PG8_SB(b, h) + boff + n * 2048 + k * 1024); } while (0)
#define PG8_MMA(ai, bj, At, Bt) do { __builtin_amdgcn_s_setprio(1); _Pragma("unroll") for (int m = 0; m < 4; ++m) _Pragma("unroll") for (int n = 0; n < 2; ++n) _Pragma("unroll") for (int k = 0; k < 2; ++k) \
        acc[ai][bj][m][n] = __builtin_amdgcn_mfma_f32_16x16x32_bf16(Bt[n][k], At[m][k], acc[ai][bj][m][n], 0, 0, 0); __builtin_amdgcn_s_setprio(0); } while (0)
#define PG8_WAIT_V(n) asm volatile("s_waitcnt vmcnt(" #n ")" ::: "memory")
#define PG8_WAIT_L(n) asm volatile("s_waitcnt lgkmcnt(" #n ")" ::: "memory")
#define PG8_BAR __builtin_amdgcn_s_barrier()
#define PG8_SCHED __builtin_amdgcn_sched_barrier(0)
    Unit cur, nxt; int ui = 0;
    if (!S.next(0, cur)) return;
    f32x4 acc[2][2][4][2];
#pragma unroll
    for (int a = 0; a < 2; ++a)
#pragma unroll
        for (int b = 0; b < 2; ++b)
#pragma unroll
            for (int m = 0; m < 4; ++m)
#pragma unroll
                for (int n = 0; n < 2; ++n) acc[a][b][m][n] = (f32x4){0.f, 0.f, 0.f, 0.f};
    bf16x8 At[4][2], B0[2][2], B1[2][2];
    const char* cA = (const char*)g.A + (size_t)cur.pm * tstep; const char* cB = (const char*)g.Bt + (size_t)cur.pn * tstep;
    S.a_ready(cur);
    if constexpr (SP2) {
        PG8_STAGE(PG8_SB(0, 0), cB, voffB); PG8_STAGE(PG8_SB(0, 1), cB + hstep, voffB); PG8_STAGE(PG8_SA(0, 0), cA, voffA); PG8_STAGE(PG8_SA(0, 1), cA + hstep, voffA);
        if (wr == 1) PG8_BAR;
        PG8_WAIT_V(2); PG8_BAR;
        PG8_STAGE(PG8_SB(1, 0), cB + kstep, voffB); PG8_STAGE(PG8_SA(1, 0), cA + kstep, voffA); PG8_STAGE(PG8_SB(1, 1), cB + hstep + kstep, voffB);
        PG8_WAIT_V(6); PG8_BAR;
    } else {
        PG8_STAGE(PG8_SB(0, 0), cB, voffB); PG8_STAGE(PG8_SA(0, 0), cA, voffA); PG8_STAGE(PG8_SB(0, 1), cB + hstep, voffB); PG8_STAGE(PG8_SA(0, 1), cA + hstep, voffA);
        if (wr == 1) PG8_BAR;
        PG8_WAIT_V(4); PG8_BAR;
        PG8_STAGE(PG8_SB(1, 0), cB + kstep, voffB); PG8_STAGE(PG8_SA(1, 0), cA + kstep, voffA); PG8_STAGE(PG8_SB(1, 1), cB + hstep + kstep, voffB);
        PG8_WAIT_V(6); PG8_BAR;
    }
    for (;;) {
        const bool has_next = S.next(ui + 1, nxt);
        const char* nA = has_next ? (const char*)g.A + (size_t)nxt.pm * tstep : cA; const char* nB = has_next ? (const char*)g.Bt + (size_t)nxt.pn * tstep : cB;
        for (int t = 0; t < nt; t += 2) {
            const bool last = (t == nt - 2);
            const char* a1 = cA + (size_t)(t + 1) * kstep;
            const char* a2 = last ? nA : cA + (size_t)(t + 2) * kstep; const char* b2 = last ? nB : cB + (size_t)(t + 2) * kstep;
            const char* a3 = a2 + kstep; const char* b3 = b2 + kstep;
            if (last && has_next) S.a_ready(nxt);
            if constexpr (SP2) {
            PG8_LDB(B0, 0, 0); PG8_LDB(B1, 0, 1); PG8_SCHED; PG8_LDA(At, 0, 0); PG8_STAGE(PG8_SA(1, 1), a1 + hstep, voffA);
            PG8_WAIT_V(8); PG8_WAIT_L(0); PG8_BAR; PG8_MMA(0, 0, At, B0); PG8_MMA(0, 1, At, B1); PG8_BAR; PG8_SCHED;
            PG8_LDA(At, 0, 1); PG8_STAGE(PG8_SB(0, 0), b2, voffB); PG8_STAGE(PG8_SB(0, 1), b2 + hstep, voffB); PG8_STAGE(PG8_SA(0, 0), a2, voffA);
            PG8_WAIT_V(8); PG8_WAIT_L(0); PG8_BAR; PG8_MMA(1, 0, At, B0); PG8_MMA(1, 1, At, B1); PG8_BAR; PG8_SCHED;
            PG8_LDB(B0, 1, 0); PG8_LDB(B1, 1, 1); PG8_SCHED; PG8_LDA(At, 1, 0); PG8_STAGE(PG8_SA(0, 1), a2 + hstep, voffA);
            PG8_WAIT_V(8); PG8_WAIT_L(0); PG8_BAR; PG8_MMA(0, 0, At, B0); PG8_MMA(0, 1, At, B1); PG8_BAR; PG8_SCHED;
            PG8_LDA(At, 1, 1); PG8_STAGE(PG8_SB(1, 0), b3, voffB); PG8_STAGE(PG8_SB(1, 1), b3 + hstep, voffB); PG8_STAGE(PG8_SA(1, 0), a3, voffA);
            PG8_WAIT_V(8); PG8_WAIT_L(0); PG8_BAR; PG8_MMA(1, 0, At, B0); PG8_MMA(1, 1, At, B1); PG8_BAR; PG8_SCHED;
            } else {
            PG8_LDB(B0, 0, 0); PG8_SCHED; PG8_LDA(At, 0, 0); PG8_STAGE(PG8_SA(1, 1), a1 + hstep, voffA);
            PG8_WAIT_L(8); PG8_BAR; PG8_WAIT_L(0); PG8_MMA(0, 0, At, B0); PG8_BAR; PG8_SCHED;
            PG8_LDB(B1, 0, 1); PG8_STAGE(PG8_SB(0, 0), b2, voffB);
            PG8_BAR; PG8_WAIT_L(0); PG8_MMA(0, 1, At, B1); PG8_BAR;
            PG8_LDA(At, 0, 1); PG8_STAGE(PG8_SA(0, 0), a2, voffA);
            PG8_BAR; PG8_WAIT_L(0); PG8_MMA(1, 0, At, B0); PG8_BAR; PG8_SCHED;
            PG8_STAGE(PG8_SB(0, 1), b2 + hstep, voffB);
            PG8_WAIT_V(6); PG8_BAR; PG8_MMA(1, 1, At, B1); PG8_BAR;
            PG8_LDB(B0, 1, 0); PG8_SCHED; PG8_LDA(At, 1, 0); PG8_STAGE(PG8_SA(0, 1), a2 + hstep, voffA);
            PG8_WAIT_L(8); PG8_BAR; PG8_WAIT_L(0); PG8_MMA(0, 0, At, B0); PG8_BAR; PG8_SCHED;
            PG8_LDB(B1, 1, 1); PG8_STAGE(PG8_SB(1, 0), b3, voffB);
            PG8_BAR; PG8_WAIT_L(0); PG8_MMA(0, 1, At, B1); PG8_BAR;
            PG8_LDA(At, 1, 1); PG8_STAGE(PG8_SA(1, 0), a3, voffA);
            PG8_BAR; PG8_WAIT_L(0); PG8_MMA(1, 0, At, B0); PG8_BAR; PG8_SCHED;
            PG8_STAGE(PG8_SB(1, 1), b3 + hstep, voffB);
            PG8_WAIT_V(6); PG8_BAR; PG8_MMA(1, 1, At, B1); PG8_BAR;
            }
        }
        if constexpr (ALIGN_EPI) { if (wr == 0) PG8_BAR; }
        if constexpr (!Epi::AFTER_DRAIN) { E(acc, cur, wr, wc, fr, fq); S.done(cur); }
        if (!has_next) break;
#pragma unroll
        for (int a = 0; a < 2; ++a)
#pragma unroll
            for (int b = 0; b < 2; ++b)
#pragma unroll
                for (int m = 0; m < 4; ++m)
#pragma unroll
                    for (int n = 0; n < 2; ++n) acc[a][b][m][n] = (f32x4){0.f, 0.f, 0.f, 0.f};
        cur = nxt; cA = nA; cB = nB; ++ui;
        if constexpr (ALIGN_EPI) { if (wr == 1) PG8_BAR; }
    }
    PG8_WAIT_V(0);
    if constexpr (!ALIGN_EPI) { if (wr == 0) PG8_BAR; }
    PG8_BAR;
    if constexpr (Epi::AFTER_DRAIN) { E.fused(acc, cur, wr, wc, fr, fq, lds, wid, lane); S.done(cur); }
#undef PG8_SA
#undef PG8_SB
#undef PG8_STAGE
#undef PG8_LDA
#undef PG8_LDB
#undef PG8_MMA
#undef PG8_WAIT_V
#undef PG8_WAIT_L
#undef PG8_BAR
#undef PG8_SCHED
}
}

#define LAS __attribute__((address_space(3)))
typedef unsigned short bf16;
typedef float f32x4 __attribute__((ext_vector_type(4)));
typedef float f32x2 __attribute__((ext_vector_type(2)));
typedef short bf16x8 __attribute__((ext_vector_type(8)));
typedef unsigned u32x4 __attribute__((ext_vector_type(4)));
typedef unsigned u32x2 __attribute__((ext_vector_type(2)));
typedef _Float16 f16x4 __attribute__((ext_vector_type(4)));

constexpr int NB = 16, T = 2048, D = 1024, M = NB * T;
constexpr int NIN = 2848, PP = 3072;
constexpr int HID = 2816, NFF = 5632;
constexpr float ALPHA = 1.189207115002721f;
constexpr float LN_EPS = 1e-5f, GN_EPS = 64e-5f;
constexpr int NWAVES = 8, NTHR = 512;
constexpr int LDS_BYTES = 147456;

constexpr size_t MiB = 1u << 20;
constexpr size_t WS_MOD = 1 * MiB, WS_STATS = WS_MOD + 512 * 1024, WS_RK = 2 * MiB;
constexpr size_t WS_WUP = 3 * MiB, WS_AUP = WS_WUP + 65536, WS_GUP = WS_AUP + 65536;
constexpr size_t WS_WIN = 4 * MiB, WS_WOUT = 10 * MiB, WS_WFFI = 12 * MiB, WS_WFFO = 23 * MiB;
constexpr size_t WS_H = 32 * MiB, WS_P = 96 * MiB, WS_E = 288 * MiB, WS_A = 320 * MiB, WS_G = 352 * MiB, WS_YRAW = 384 * MiB, WS_Y = 448 * MiB, WS_END = 512 * MiB;
constexpr size_t WS_X1 = 288 * MiB;
constexpr size_t WS_HID = 96 * MiB;

enum { I_X = 0, I_C, I_EG, I_EB, I_WADA, I_BADA, I_WIN, I_MU, I_SGG, I_SGB, I_WS, I_BS, I_W0, I_WUP, I_A0, I_AUP, I_GUP, I_KK, I_KA, I_RK, I_LXG, I_LXB, I_WOUT, I_L1G, I_L1B, I_WFFI, I_WFFO, I_L2G, I_L2B, N_IN };

__device__ __forceinline__ unsigned f2bf(float f) { unsigned u = __builtin_bit_cast(unsigned, f); return (u + 0x7fffu + ((u >> 16) & 1u)) >> 16; }
__device__ __forceinline__ unsigned pk2(float lo, float hi) { return f2bf(lo) | (f2bf(hi) << 16); }
__device__ __forceinline__ u32x2 pk4(f32x4 v) { u32x2 r; r.x = pk2(v.x, v.y); r.y = pk2(v.z, v.w); return r; }
__device__ __forceinline__ f32x4 unpk4(u32x2 u) { f32x4 r; r.x = __uint_as_float(u.x << 16); r.y = __uint_as_float(u.x & 0xffff0000u); r.z = __uint_as_float(u.y << 16); r.w = __uint_as_float(u.y & 0xffff0000u); return r; }
__device__ __forceinline__ float bf_lo(unsigned u) { return __uint_as_float(u << 16); }
__device__ __forceinline__ float bf_hi(unsigned u) { return __uint_as_float(u & 0xffff0000u); }
__device__ __forceinline__ float sigmoidf_(float x) { return __builtin_amdgcn_rcpf(1.0f + __builtin_amdgcn_exp2f(-1.4426950408889634f * x)); }
__device__ __forceinline__ float gelu_tanh(float x) { return x * __builtin_amdgcn_rcpf(1.0f + __builtin_amdgcn_exp2f(-2.302208198f * x * (1.0f + 0.044715f * x * x))); }
#define LDS_WAIT() asm volatile("s_waitcnt lgkmcnt(0)" ::: "memory")

template <int CTRL> __device__ __forceinline__ float dppx(float x) { return __int_as_float(__builtin_amdgcn_update_dpp(0, __float_as_int(x), CTRL, 0xf, 0xf, true)); }
__device__ __forceinline__ float reduce4(float x) { x += dppx<0xB1>(x); x += dppx<0x4E>(x); return x; }
__device__ __forceinline__ float reduce16(float x) { x += dppx<0xB1>(x); x += dppx<0x4E>(x); x += dppx<0x141>(x); x += dppx<0x140>(x); return x; }
__device__ __forceinline__ float wave_sum(float v) {
#pragma unroll
    for (int o = 1; o < 64; o <<= 1) v += __shfl_xor(v, o);
    return v;
}

namespace pg8 {
struct EpiP {
    static constexpr bool PERM = true, AFTER_DRAIN = false;
    bf16_t* O;
    __device__ __forceinline__ void operator()(const f32x4 (&acc)[2][2][4][2], const Unit& u, int wr, int wc, int fr, int fq) const {
        const int row0 = u.pm * BM + wr * 64 + fr, col0 = u.pn * BM + wc * 32 + 8 * fq; const bool act = u.pn < 4;
#pragma unroll
        for (int ai = 0; ai < 2; ++ai)
#pragma unroll
            for (int m = 0; m < 4; ++m) { bf16_t* rowp = O + (size_t)(row0 + ai * HALF + m * 16) * PP + col0;
#pragma unroll
                for (int bj = 0; bj < 2; ++bj) { f32x4 v0 = acc[ai][bj][m][0], v1 = acc[ai][bj][m][1];
                    if (act) {
#pragma unroll
                        for (int e = 0; e < 4; ++e) { v0[e] = gelu_tanh(v0[e]); v1[e] = gelu_tanh(v1[e]); } }
                    u32x4 w; w.x = cvt_pk_bf16(v0[0], v0[1]); w.y = cvt_pk_bf16(v0[2], v0[3]); w.z = cvt_pk_bf16(v1[0], v1[1]); w.w = cvt_pk_bf16(v1[2], v1[3]);
                    *(u32x4*)(rowp + bj * HALF) = w; } }
    }
};
struct EpiZ1 {
    static constexpr bool PERM = false, AFTER_DRAIN = false;
    const float* x; const float* stats; const float* eg; const float* eb; const float* mod; float* out;
    __device__ __forceinline__ void operator()(const f32x4 (&acc)[2][2][4][2], const Unit& u, int wr, int wc, int fr, int fq) const {
        const int b = u.pm >> 3, col0 = u.pn * BM + wc * 32 + 4 * fq;
#pragma unroll
        for (int bj = 0; bj < 2; ++bj)
#pragma unroll
            for (int n = 0; n < 2; ++n) { const int c = col0 + bj * HALF + n * 16;
                const f32x4 g4 = *(const f32x4*)(eg + c), b4 = *(const f32x4*)(eb + c), gt = *(const f32x4*)(mod + b * 6144 + 2048 + c);
#pragma unroll
                for (int ai = 0; ai < 2; ++ai)
#pragma unroll
                    for (int m = 0; m < 4; ++m) { const int r = u.pm * BM + ai * HALF + wr * 64 + m * 16 + fr; const f32x2 st = *(const f32x2*)(stats + 2 * r);
                        const size_t off = (size_t)r * D + c; const f32x4 xv = *(const f32x4*)(x + off);
                        const f32x4 x0 = (xv - st.x) * st.y * g4 + b4;
                        *(f32x4*)(out + off) = x0 * ALPHA + gt * acc[ai][bj][m][n]; } }
    }
};
struct EpiHid {
    static constexpr bool PERM = true, AFTER_DRAIN = false;
    bf16_t* O;
    __device__ __forceinline__ void operator()(const f32x4 (&acc)[2][2][4][2], const Unit& u, int wr, int wc, int fr, int fq) const {
        const int row0 = u.pm * BM + wr * 64 + fr, col0 = u.pn * HALF + wc * 32 + 8 * fq;
#pragma unroll
        for (int ai = 0; ai < 2; ++ai)
#pragma unroll
            for (int m = 0; m < 4; ++m) { bf16_t* rowp = O + (size_t)(row0 + ai * HALF + m * 16) * HID + col0;
                f32x4 h0, h1;
#pragma unroll
                for (int e = 0; e < 4; ++e) { const float g0 = acc[ai][0][m][0][e], g1 = acc[ai][0][m][1][e];
                    h0[e] = g0 * sigmoidf_(g0) * acc[ai][1][m][0][e]; h1[e] = g1 * sigmoidf_(g1) * acc[ai][1][m][1][e]; }
                u32x4 w; w.x = cvt_pk_bf16(h0[0], h0[1]); w.y = cvt_pk_bf16(h0[2], h0[3]); w.z = cvt_pk_bf16(h1[0], h1[1]); w.w = cvt_pk_bf16(h1[2], h1[3]);
                *(u32x4*)rowp = w; }
    }
};
struct EpiZ2 {
    static constexpr bool PERM = false, AFTER_DRAIN = false;
    const float* x1; const float* mod; float* out;
    __device__ __forceinline__ void operator()(const f32x4 (&acc)[2][2][4][2], const Unit& u, int wr, int wc, int fr, int fq) const {
        const int b = u.pm >> 3, col0 = u.pn * BM + wc * 32 + 4 * fq;
#pragma unroll
        for (int bj = 0; bj < 2; ++bj)
#pragma unroll
            for (int n = 0; n < 2; ++n) { const int c = col0 + bj * HALF + n * 16; const f32x4 gt = *(const f32x4*)(mod + b * 6144 + 5120 + c);
#pragma unroll
                for (int ai = 0; ai < 2; ++ai)
#pragma unroll
                    for (int m = 0; m < 4; ++m) { const int r = u.pm * BM + ai * HALF + wr * 64 + m * 16 + fr; const size_t off = (size_t)r * D + c;
                        *(f32x4*)(out + off) = *(const f32x4*)(x1 + off) * ALPHA + gt * acc[ai][bj][m][n]; } }
    }
};
}

struct Args { const float* in[N_IN]; float* out; unsigned char* ws; int ph_lo, ph_hi; };
static_assert(sizeof(Args) == (N_IN + 2) * 8 + 8, "Args has no padding");

__device__ __forceinline__ void transpose_item(const float* W, int K, int N, bf16* WT, int k0, int n0, int dst_row0, LAS float* scr, int lane) {
#pragma unroll 8
    for (int i = 0; i < 32; ++i) { const int kk = 2 * i + (lane >> 5); scr[kk * 33 + (lane & 31)] = W[(size_t)(k0 + kk) * N + n0 + (lane & 31)]; }
    LDS_WAIT(); asm volatile("" ::: "memory");
    const int c = lane & 7;
#pragma unroll
    for (int j = 0; j < 4; ++j) { const int n = (lane >> 3) + 8 * j; const LAS float* s = scr + (8 * c) * 33 + n;
        u32x4 o; o.x = pk2(s[0 * 33], s[1 * 33]); o.y = pk2(s[2 * 33], s[3 * 33]); o.z = pk2(s[4 * 33], s[5 * 33]); o.w = pk2(s[6 * 33], s[7 * 33]);
        *(u32x4*)(WT + (size_t)(dst_row0 + n) * K + k0 + 8 * c) = o; }
    LDS_WAIT(); asm volatile("" ::: "memory");
}

__device__ __forceinline__ void p0_prologue(const Args& a, LAS unsigned char* lds, int tid, int lane, int wave, int vcu, int G) {
    unsigned char* ws = a.ws;
    if (blockIdx.x < 96) {
        const int col0 = blockIdx.x * 64;
        LAS float* sc = (LAS float*)(lds + 65536 + wave * 8192);
        const float* c = a.in[I_C];
        for (int i = 0; i < 32; ++i) { const int idx = i * 64 + lane, b = idx >> 7, k = idx & 127; const float cv = c[b * 1024 + 128 * wave + k]; sc[idx] = cv * sigmoidf_(cv); }
        LDS_WAIT(); asm volatile("" ::: "memory");
        float acc[16];
#pragma unroll
        for (int b = 0; b < 16; ++b) acc[b] = 0.f;
        const float* W = a.in[I_WADA] + (size_t)(128 * wave) * 6144 + col0 + lane;
        for (int k4 = 0; k4 < 32; ++k4) {
            const float w0 = W[(size_t)(4 * k4 + 0) * 6144], w1 = W[(size_t)(4 * k4 + 1) * 6144], w2 = W[(size_t)(4 * k4 + 2) * 6144], w3 = W[(size_t)(4 * k4 + 3) * 6144];
#pragma unroll
            for (int b = 0; b < 16; ++b) { const f32x4 s4 = *(const LAS f32x4*)(sc + b * 128 + 4 * k4); acc[b] += s4.x * w0 + s4.y * w1 + s4.z * w2 + s4.w * w3; }
        }
        LAS float* red = (LAS float*)lds;
#pragma unroll
        for (int b = 0; b < 16; ++b) red[(wave * 16 + b) * 64 + lane] = acc[b];
        __syncthreads();
        float* mod = (float*)(ws + WS_MOD);
        for (int o = tid; o < 1024; o += NTHR) { const int b = o >> 6, l = o & 63; float s = a.in[I_BADA][col0 + l];
#pragma unroll
            for (int w = 0; w < 8; ++w) s += red[(w * 16 + b) * 64 + l];
            mod[b * 6144 + col0 + l] = s; }
        __syncthreads();
    }
    LAS float* scr = (LAS float*)(lds + wave * 16384);
    const int gw = vcu * NWAVES + wave, NGW = G * NWAVES;
    constexpr int NB_IN = NIN / 32, I_IN = 16 * NB_IN, I_OUT = 16 * 32, NB_FFI = NFF / 32, I_FFI = 16 * NB_FFI, I_FFO = (HID / 64) * 32;
    constexpr int NITEMS = I_IN + I_OUT + I_FFI + I_FFO;
    bf16* Win = (bf16*)(ws + WS_WIN); bf16* Wout = (bf16*)(ws + WS_WOUT); bf16* Wffi = (bf16*)(ws + WS_WFFI); bf16* Wffo = (bf16*)(ws + WS_WFFO);
    for (int it = gw; it < NITEMS; it += NGW) {
        int r = it;
        if (r < I_IN) { const int kb = r / NB_IN, nb = r % NB_IN; transpose_item(a.in[I_WIN], D, NIN, Win, 64 * kb, 32 * nb, 32 * nb, scr, lane); continue; } r -= I_IN;
        if (r < I_OUT) { const int kb = r / 32, nb = r % 32; transpose_item(a.in[I_WOUT], D, D, Wout, 64 * kb, 32 * nb, 32 * nb, scr, lane); continue; } r -= I_OUT;
        if (r < I_FFI) { const int kb = r / NB_FFI, nb = r % NB_FFI; const int n0 = 32 * nb; const int nn = n0 < HID ? n0 : n0 - HID; const int dst = 256 * (nn / 128) + (nn % 128) + (n0 < HID ? 0 : 128);
            transpose_item(a.in[I_WFFI], D, NFF, Wffi, 64 * kb, n0, dst, scr, lane); continue; } r -= I_FFI;
        { const int kb = r / 32, nb = r % 32; transpose_item(a.in[I_WFFO], HID, D, Wffo, 64 * kb, 32 * nb, 32 * nb, scr, lane); }
    }
    const int gt = vcu * NTHR + tid, NGT = G * NTHR;
    for (int i = gt; i < (PP - NIN) * D / 8; i += NGT) ((u32x4*)(Win + (size_t)NIN * D))[i] = (u32x4){0u, 0u, 0u, 0u};
    bf16* wup = (bf16*)(ws + WS_WUP); bf16* aup = (bf16*)(ws + WS_AUP); bf16* gup = (bf16*)(ws + WS_GUP);
    for (int i = gt; i < 512 * 64; i += NGT) { const int n = i >> 6, k = i & 63; wup[i] = (bf16)f2bf(a.in[I_WUP][k * 512 + n]); aup[i] = (bf16)f2bf(a.in[I_AUP][k * 512 + n]); }
    for (int i = gt; i < 512 * 160; i += NGT) { const int n = i / 160, k = i % 160; gup[i] = (bf16)f2bf(a.in[I_GUP][k * 512 + n]); }
}

template <int MODE>
__device__ __forceinline__ void ln_rows(const float* src, const float* g, const float* bvec, const float* mod, float* stats, float* fout, bf16* hout, int lane, int gw, int NGW) {
    for (int m = gw; m < M; m += NGW) {
        const f32x4* xr = (const f32x4*)(src + (size_t)m * D) + lane;
        f32x4 v[4]; float s = 0.f;
#pragma unroll
        for (int j = 0; j < 4; ++j) { v[j] = xr[64 * j]; s += (v[j].x + v[j].y) + (v[j].z + v[j].w); }
        const float mean = wave_sum(s) * (1.f / D); float s2 = 0.f;
#pragma unroll
        for (int j = 0; j < 4; ++j) { v[j] = v[j] - mean; s2 += (v[j].x * v[j].x + v[j].y * v[j].y) + (v[j].z * v[j].z + v[j].w * v[j].w); }
        const float rstd = 1.f / sqrtf(wave_sum(s2) * (1.f / D) + LN_EPS);
        if (MODE == 0 && lane == 0) { stats[2 * m] = mean; stats[2 * m + 1] = rstd; }
        const int b = m >> 11;
#pragma unroll
        for (int j = 0; j < 4; ++j) { const int c = 4 * (lane + 64 * j);
            const f32x4 y = v[j] * rstd * *(const f32x4*)(g + c) + *(const f32x4*)(bvec + c);
            if (MODE == 1 || MODE == 2) *(f32x4*)(fout + (size_t)m * D + c) = y;
            if (MODE == 0 || MODE == 1) { const float* mb = mod + b * 6144 + (MODE == 0 ? 0 : 3072);
                const f32x4 hv = y * (*(const f32x4*)(mb + 1024 + c) + 1.0f) + *(const f32x4*)(mb + c);
                *(u32x2*)(hout + (size_t)m * D + c) = pk4(hv); } }
    }
}

__device__ __forceinline__ void lora_prep(const Args& a, int lane, int wave, int vcu) {
    unsigned char* ws = a.ws;
    const bf16* p = (const bf16*)(ws + WS_P); const bf16* wup = (const bf16*)(ws + WS_WUP); const bf16* aup = (const bf16*)(ws + WS_AUP); const bf16* gup = (const bf16*)(ws + WS_GUP);
    _Float16* E = (_Float16*)(ws + WS_E); bf16* A = (bf16*)(ws + WS_A); bf16* Gt = (bf16*)(ws + WS_G);
    const float* mu = a.in[I_MU];
    const int fr = lane & 15, fq = lane >> 4;
    const int row = (vcu * NWAVES + wave) * 16 + fr;
    const bool hp = (row & (T - 1)) != 0;
    const bf16* cur = p + (size_t)row * PP + 1024 + 1536 + 8 * fq; const bf16* prv = hp ? cur - PP : cur;
    bf16x8 Bf[9];
#pragma unroll
    for (int s = 0; s < 9; ++s) {
        const int cofs = 32 * s;
        const u32x4 cu = *(const u32x4*)(cur + cofs), pu = *(const u32x4*)(prv + cofs);
        const f32x4 m0 = *(const f32x4*)(mu + 1536 + cofs + 8 * fq), m1 = *(const f32x4*)(mu + 1536 + cofs + 8 * fq + 4);
        float xs[8];
#pragma unroll
        for (int j = 0; j < 4; ++j) { const unsigned cw = cu[j], pw = hp ? pu[j] : 0u; const float c0 = bf_lo(cw), c1 = bf_hi(cw), p0 = bf_lo(pw), p1 = bf_hi(pw);
            const float mm0 = j < 2 ? m0[2 * j] : m1[2 * j - 4], mm1 = j < 2 ? m0[2 * j + 1] : m1[2 * j - 3];
            xs[2 * j] = c0 + (p0 - c0) * mm0; xs[2 * j + 1] = c1 + (p1 - c1) * mm1; }
#pragma unroll
        for (int j = 0; j < 8; ++j) { if (s < 2) xs[j] = 2.0f * sigmoidf_(2.0f * xs[j]) - 1.0f; else if (s >= 4) xs[j] = sigmoidf_(xs[j]); }
        u32x4 w; w.x = pk2(xs[0], xs[1]); w.y = pk2(xs[2], xs[3]); w.z = pk2(xs[4], xs[5]); w.w = pk2(xs[6], xs[7]);
        Bf[s] = __builtin_bit_cast(bf16x8, w);
    }
    const float* w0 = a.in[I_W0]; const float* a0 = a.in[I_A0];
    for (int ct = 0; ct < 32; ++ct) {
        const int ch = 16 * ct + fr;
        f32x4 aw = {0.f, 0.f, 0.f, 0.f}, aa = aw, ag = aw;
#pragma unroll
        for (int s = 0; s < 2; ++s) { const bf16x8 fw = *(const bf16x8*)(wup + ch * 64 + 32 * s + 8 * fq); aw = __builtin_amdgcn_mfma_f32_16x16x32_bf16(fw, Bf[s], aw, 0, 0, 0); }
#pragma unroll
        for (int s = 0; s < 2; ++s) { const bf16x8 fa = *(const bf16x8*)(aup + ch * 64 + 32 * s + 8 * fq); aa = __builtin_amdgcn_mfma_f32_16x16x32_bf16(fa, Bf[2 + s], aa, 0, 0, 0); }
#pragma unroll
        for (int s = 0; s < 5; ++s) { const bf16x8 fg = *(const bf16x8*)(gup + ch * 160 + 32 * s + 8 * fq); ag = __builtin_amdgcn_mfma_f32_16x16x32_bf16(fg, Bf[4 + s], ag, 0, 0, 0); }
        const int c0 = 16 * ct + 4 * fq;
        const f32x4 w04 = *(const f32x4*)(w0 + c0), a04 = *(const f32x4*)(a0 + c0);
        f32x4 ev, av;
#pragma unroll
        for (int e = 0; e < 4; ++e) { ev[e] = 0.6065306597126334f * sigmoidf_(w04[e] + aw[e]); av[e] = sigmoidf_(a04[e] + aa[e]); }
        const size_t o = (size_t)row * 512 + c0;
        *(f16x4*)(E + o) = __builtin_convertvector(ev, f16x4);
        *(u32x2*)(A + o) = pk4(av);
        *(u32x2*)(Gt + o) = pk4(ag);
    }
}

__device__ __forceinline__ int swz256(int row, int k) { return row * 256 + ((((k >> 3) ^ (row & 15))) << 4) + (k & 7) * 2; }
__device__ __forceinline__ void gmlp_unit(const Args& a, LAS unsigned char* lds, int tid, int lane, int wave, int unit) {
    unsigned char* ws = a.ws;
    const bf16* p = (const bf16*)(ws + WS_P); bf16* Y = (bf16*)(ws + WS_Y);
    const int rowB = unit * 128;
    LAS unsigned char* WL = lds; LAS unsigned char* VT = lds + 32768; LAS float* st = (LAS float*)(lds + 65536);
    {
        const int r = tid >> 2, part = tid & 3; const bf16* q = p + (size_t)(rowB + r) * PP + 512 + 128 * part;
        float s = 0.f, s2 = 0.f;
#pragma unroll
        for (int i = 0; i < 16; ++i) { const u32x4 w = *(const u32x4*)(q + 8 * i);
#pragma unroll
            for (int j = 0; j < 4; ++j) { const float x0 = bf_lo(w[j]), x1 = bf_hi(w[j]); s += x0 + x1; s2 += x0 * x0 + x1 * x1; } }
        s = reduce4(s); s2 = reduce4(s2);
        const float mean = s * (1.f / 512.f), var = fmaxf(s2 * (1.f / 512.f) - mean * mean, 0.f);
        if (part == 0) { st[2 * r] = mean; st[2 * r + 1] = 1.f / sqrtf(var + LN_EPS); }
    }
    __syncthreads();
    const int fr = lane & 15, fq = lane >> 4;
    for (int g = 0; g < 4; ++g) {
        const float* Wg = a.in[I_WS] + (size_t)g * 128 * 128;
#pragma unroll
        for (int i = 0; i < 4; ++i) { const int idx = tid + i * NTHR, t = idx >> 4, ck = idx & 15;
            const f32x4 w0 = *(const f32x4*)(Wg + t * 128 + 8 * ck), w1 = *(const f32x4*)(Wg + t * 128 + 8 * ck + 4);
            float x[8] = {w0.x, w0.y, w0.z, w0.w, w1.x, w1.y, w1.z, w1.w};
#pragma unroll
            for (int j = 0; j < 8; ++j) if (8 * ck + j > t) x[j] = 0.f;
            u32x4 o; o.x = pk2(x[0], x[1]); o.y = pk2(x[2], x[3]); o.z = pk2(x[4], x[5]); o.w = pk2(x[6], x[7]);
            *(LAS u32x4*)(WL + swz256(t, 8 * ck)) = o; }
#pragma unroll
        for (int i = 0; i < 4; ++i) { const int idx = tid + i * NTHR, s = idx >> 4, dc = idx & 15;
            const u32x4 w = *(const u32x4*)(p + (size_t)(rowB + s) * PP + 512 + 128 * g + 8 * dc);
            const float mean = st[2 * s], rstd = st[2 * s + 1];
            const f32x4 g0 = *(const f32x4*)(a.in[I_SGG] + 128 * g + 8 * dc), g1 = *(const f32x4*)(a.in[I_SGG] + 128 * g + 8 * dc + 4);
            const f32x4 b0 = *(const f32x4*)(a.in[I_SGB] + 128 * g + 8 * dc), b1 = *(const f32x4*)(a.in[I_SGB] + 128 * g + 8 * dc + 4);
#pragma unroll
            for (int j = 0; j < 8; ++j) { const float x = (j & 1) ? bf_hi(w[j >> 1]) : bf_lo(w[j >> 1]); const float gg = j < 4 ? g0[j] : g1[j - 4], bb = j < 4 ? b0[j] : b1[j - 4];
                const float v = (x - mean) * rstd * gg + bb;
                *(LAS unsigned short*)(VT + swz256(8 * dc + j, s)) = (unsigned short)f2bf(v); } }
        __syncthreads();
        f32x4 acc[8];
#pragma unroll
        for (int dt = 0; dt < 8; ++dt) acc[dt] = (f32x4){0.f, 0.f, 0.f, 0.f};
        const int nks = ((16 * wave + 15) >> 5) + 1;
        for (int ks = 0; ks < nks; ++ks) {
            const bf16x8 bfrag = *(const LAS bf16x8*)(WL + swz256(16 * wave + fr, 32 * ks + 8 * fq));
#pragma unroll
            for (int dt = 0; dt < 8; ++dt) { const bf16x8 afrag = *(const LAS bf16x8*)(VT + swz256(16 * dt + fr, 32 * ks + 8 * fq));
                acc[dt] = __builtin_amdgcn_mfma_f32_16x16x32_bf16(afrag, bfrag, acc[dt], 0, 0, 0); }
        }
        const int t = 16 * wave + fr; const float bs = a.in[I_BS][g * 128 + t];
        const bf16* up = p + (size_t)(rowB + t) * PP + 128 * g + 4 * fq; bf16* yp = Y + (size_t)(rowB + t) * D + 128 * g + 4 * fq;
#pragma unroll
        for (int dt = 0; dt < 8; ++dt) { const f32x4 uv = unpk4(*(const u32x2*)(up + 16 * dt)); *(u32x2*)(yp + 16 * dt) = pk4(uv * (acc[dt] + bs)); }
        __syncthreads();
    }
}

struct ScanRaw { u32x2 rc, rp, kc, kp, vc, vp, e, a; };
__device__ __forceinline__ void scan_load(ScanRaw& R, const bf16* p, const _Float16* E, const bf16* A, size_t row, bool hp, int colh) {
    const bf16* cur = p + row * PP + 1024 + colh; const bf16* prv = hp ? cur - PP : cur;
    R.rc = *(const u32x2*)(cur); R.kc = *(const u32x2*)(cur + 512); R.vc = *(const u32x2*)(cur + 1024);
    R.rp = *(const u32x2*)(prv); R.kp = *(const u32x2*)(prv + 512); R.vp = *(const u32x2*)(prv + 1024);
    if (!hp) { R.rp = (u32x2){0u, 0u}; R.kp = R.rp; R.vp = R.rp; }
    R.e = *(const u32x2*)(E + row * 512 + colh); R.a = *(const u32x2*)(A + row * 512 + colh);
}
constexpr int SC_CT = 32, SC_BUF = 5 * SC_CT * 64 + SC_CT * 32;
__device__ __forceinline__ void scan_phase(const Args& a, LAS unsigned char* lds, int tid, int lane, int wave, int vcu) {
    unsigned char* ws = a.ws;
    const bf16* p = (const bf16*)(ws + WS_P); const _Float16* E = (const _Float16*)(ws + WS_E); const bf16* A = (const bf16*)(ws + WS_A);
    float* yraw = (float*)(ws + WS_YRAW); float* rkout = (float*)(ws + WS_RK);
    const int bh = vcu >> 1, half = vcu & 1, b = bh >> 3, h = bh & 7;
    const size_t row0 = (size_t)b * T;
    const int tp = tid >> 4, cs = tid & 15, colh = 64 * h + 4 * cs;
    LAS float* bufs = (LAS float*)lds; LAS float* Ybuf = (LAS float*)(lds + 2 * SC_BUF * 4);
    const float* mu = a.in[I_MU];
    const f32x4 mur = *(const f32x4*)(mu + colh), muk = *(const f32x4*)(mu + 512 + colh), muv = *(const f32x4*)(mu + 1024 + colh);
    const f32x4 kkc = *(const f32x4*)(a.in[I_KK] + colh), kac = *(const f32x4*)(a.in[I_KA] + colh), rkc = *(const f32x4*)(a.in[I_RK] + colh);
    ScanRaw R;
    auto prep = [&](int c) {
        LAS float* buf = bufs + (c & 1) * SC_BUF;
        const f32x4 rc = unpk4(R.rc), rp = unpk4(R.rp), kc = unpk4(R.kc), kp_ = unpk4(R.kp), vc = unpk4(R.vc), vp = unpk4(R.vp);
        const f32x4 rs = rc + (rp - rc) * mur, ks = kc + (kp_ - kc) * muk, vs = vc + (vp - vc) * muv;
        const f32x4 ev = __builtin_convertvector(__builtin_bit_cast(f16x4, R.e), f32x4), av = unpk4(R.a);
        f32x4 kk = ks * kkc;
        float n2 = (kk.x * kk.x + kk.y * kk.y) + (kk.z * kk.z + kk.w * kk.w); n2 = reduce16(n2);
        const float inv = 1.0f / fmaxf(sqrtf(n2), 1e-12f);
        kk = kk * inv;
        const f32x4 kpr = ks * ((av - 1.0f) * kac + 1.0f);
        const f32x4 rkp = rs * kpr * rkc; float rk = (rkp.x + rkp.y) + (rkp.z + rkp.w); rk = reduce16(rk);
        f32x4 wv;
#pragma unroll
        for (int e = 0; e < 4; ++e) wv[e] = __builtin_amdgcn_exp2f(-1.4426950408889634f * ev[e]);
        *(LAS f32x4*)(buf + tp * 64 + 4 * cs) = wv;
        *(LAS f32x4*)(buf + 2048 + tp * 64 + 4 * cs) = -kk;
        *(LAS f32x4*)(buf + 4096 + tp * 64 + 4 * cs) = kk * av;
        *(LAS f32x4*)(buf + 6144 + tp * 64 + 4 * cs) = kpr;
        *(LAS f32x4*)(buf + 8192 + tp * 64 + 4 * cs) = rs;
        if ((cs >> 3) == half) *(LAS f32x4*)(buf + 10240 + tp * 32 + 4 * (cs & 7)) = vs;
        if (half == 0 && cs == 0) rkout[(row0 + (size_t)c * SC_CT + tp) * 8 + h] = rk;
    };
    scan_load(R, p, E, A, row0 + tp, tp != 0, colh);
    prep(0);
    __syncthreads();
    float S0 = 0.f, S1 = 0.f, S2 = 0.f, S3 = 0.f;
    constexpr int NCH = T / SC_CT;
    for (int c = 0; c < NCH; ++c) {
        if (c + 1 < NCH) scan_load(R, p, E, A, row0 + (size_t)(c + 1) * SC_CT + tp, true, colh);
        const LAS float* buf = bufs + (c & 1) * SC_BUF; LAS float* Yb = Ybuf + (c & 1) * (SC_CT * 32);
#pragma unroll 4
        for (int t = 0; t < SC_CT; ++t) {
            const f32x4 wv = *(const LAS f32x4*)(buf + t * 64 + 4 * cs), av = *(const LAS f32x4*)(buf + 2048 + t * 64 + 4 * cs), bv = *(const LAS f32x4*)(buf + 4096 + t * 64 + 4 * cs);
            const f32x4 kv = *(const LAS f32x4*)(buf + 6144 + t * 64 + 4 * cs), rv = *(const LAS f32x4*)(buf + 8192 + t * 64 + 4 * cs);
            const float vi = buf[10240 + t * 32 + tp];
            float sa = (S0 * av.x + S1 * av.y) + (S2 * av.z + S3 * av.w); sa = reduce16(sa);
            S0 = S0 * wv.x + (sa * bv.x + vi * kv.x); S1 = S1 * wv.y + (sa * bv.y + vi * kv.y); S2 = S2 * wv.z + (sa * bv.z + vi * kv.z); S3 = S3 * wv.w + (sa * bv.w + vi * kv.w);
            float y = (S0 * rv.x + S1 * rv.y) + (S2 * rv.z + S3 * rv.w); y = reduce16(y);
            if (cs == 0) Yb[t * 32 + tp] = y;
        }
        if (c + 1 < NCH) prep(c + 1);
        __syncthreads();
        { const f32x2 yv = *(const LAS f32x2*)(Yb + tp * 32 + 2 * cs);
          *(f32x2*)(yraw + (row0 + (size_t)c * SC_CT + tp) * 512 + 64 * h + 32 * half + 2 * cs) = yv; }
    }
}

__device__ __forceinline__ void rwkv_post(const Args& a, int tid, int vcu) {
    unsigned char* ws = a.ws;
    const bf16* p = (const bf16*)(ws + WS_P); const float* yraw = (const float*)(ws + WS_YRAW); const float* rk = (const float*)(ws + WS_RK); const bf16* Gt = (const bf16*)(ws + WS_G);
    bf16* Y = (bf16*)(ws + WS_Y);
    const int cs = tid & 15; const float* mu = a.in[I_MU];
    for (int it = 0; it < 32; ++it) {
        const int pair = it * 32 + (tid >> 4), row = vcu * 128 + (pair >> 3), h = pair & 7, c = 64 * h + 4 * cs;
        const f32x4 y4 = *(const f32x4*)(yraw + (size_t)row * 512 + c);
        float s = (y4.x + y4.y) + (y4.z + y4.w); s = reduce16(s); const float mean = s * (1.f / 64.f);
        const f32x4 d = y4 - mean; float q = (d.x * d.x + d.y * d.y) + (d.z * d.z + d.w * d.w); q = reduce16(q);
        const float rstd = 1.f / sqrtf(q * (1.f / 64.f) + GN_EPS);
        const f32x4 yn = d * rstd * *(const f32x4*)(a.in[I_LXG] + c) + *(const f32x4*)(a.in[I_LXB] + c);
        const bool hp = (row & (T - 1)) != 0;
        const bf16* cur = p + (size_t)row * PP + 2048 + c; const bf16* prv = hp ? cur - PP : cur;
        const f32x4 vc = unpk4(*(const u32x2*)cur); f32x4 vp = unpk4(*(const u32x2*)prv); if (!hp) vp = (f32x4){0.f, 0.f, 0.f, 0.f};
        const f32x4 vs = vc + (vp - vc) * *(const f32x4*)(mu + 1024 + c);
        const float rkv = rk[(size_t)row * 8 + h];
        const f32x4 g4 = unpk4(*(const u32x2*)(Gt + (size_t)row * 512 + c));
        *(u32x2*)(Y + (size_t)row * D + 512 + c) = pk4((yn + vs * rkv) * g4);
    }
}

__global__ void __launch_bounds__(NTHR, 2) fwd_kernel(Args args) {
    extern __shared__ __attribute__((aligned(16))) unsigned char lds_raw[];
    LAS unsigned char* lds = (LAS unsigned char*)lds_raw;
    cg::grid_group grid = cg::this_grid();
    const int tid = threadIdx.x, lane = tid & 63, wave = __builtin_amdgcn_readfirstlane(tid >> 6);
    const int G = gridDim.x, bx = blockIdx.x, vcu = (G % 8 == 0) ? (bx % 8) * (G / 8) + bx / 8 : bx;
    const int gw = vcu * NWAVES + wave, NGW = G * NWAVES;
    unsigned char* ws = args.ws;
    const int lo = args.ph_lo, hi = args.ph_hi;
#define IN(k) (lo <= (k) && (k) < hi)
#define SEAM(k) do { if (IN(k) && IN((k) + 1)) grid.sync(); } while (0)
    float* mod = (float*)(ws + WS_MOD); float* stats = (float*)(ws + WS_STATS);
    bf16* Hb = (bf16*)(ws + WS_H); bf16* Pb = (bf16*)(ws + WS_P); bf16* Yb = (bf16*)(ws + WS_Y); bf16* HIDb = (bf16*)(ws + WS_HID); float* X1 = (float*)(ws + WS_X1);

    if (IN(0)) { p0_prologue(args, lds, tid, lane, wave, vcu, G); } SEAM(0);
    if (IN(1)) { ln_rows<0>(args.in[I_X], args.in[I_EG], args.in[I_EB], mod, stats, nullptr, Hb, lane, gw, NGW); } SEAM(1);
    if (IN(2)) {
        pg8::Gemm g{Hb, (const bf16*)(ws + WS_WIN), M, PP, D}; pg8::StaticOrder S; S.init(M, PP, G, bx);
        pg8::EpiP E{Pb};
        pg8::gemm_phase<pg8::EpiP, pg8::StaticOrder, true, true>(lds, g, S, E);
    } SEAM(2);
    if (IN(3)) { lora_prep(args, lane, wave, vcu); gmlp_unit(args, lds, tid, lane, wave, vcu); } SEAM(3);
    if (IN(4)) { scan_phase(args, lds, tid, lane, wave, vcu); } SEAM(4);
    if (IN(5)) { rwkv_post(args, tid, vcu); } SEAM(5);
    if (IN(6)) {
        pg8::Gemm g{Yb, (const bf16*)(ws + WS_WOUT), M, D, D}; pg8::StaticOrder S; S.init(M, D, G, bx);
        pg8::EpiZ1 E{args.in[I_X], stats, args.in[I_EG], args.in[I_EB], mod, args.out};
        pg8::gemm_phase<pg8::EpiZ1, pg8::StaticOrder, true, true>(lds, g, S, E);
    } SEAM(6);
    if (IN(7)) { ln_rows<1>(args.out, args.in[I_L1G], args.in[I_L1B], mod, nullptr, X1, Hb, lane, gw, NGW); } SEAM(7);
    if (IN(8)) {
        pg8::Gemm g{Hb, (const bf16*)(ws + WS_WFFI), M, NFF, D}; pg8::StaticOrder S; S.init(M, NFF, G, bx);
        pg8::EpiHid E{HIDb};
        pg8::gemm_phase<pg8::EpiHid, pg8::StaticOrder, true, true>(lds, g, S, E);
    } SEAM(8);
    if (IN(9)) {
        pg8::Gemm g{HIDb, (const bf16*)(ws + WS_WFFO), M, D, HID}; pg8::StaticOrder S; S.init(M, D, G, bx);
        pg8::EpiZ2 E{X1, mod, args.out};
        pg8::gemm_phase<pg8::EpiZ2, pg8::StaticOrder, true, true>(lds, g, S, E);
    } SEAM(9);
    if (IN(10)) { ln_rows<2>(args.out, args.in[I_L2G], args.in[I_L2B], mod, nullptr, args.out, nullptr, lane, gw, NGW); }
#undef IN
#undef SEAM
}

extern "C" void kernel_launch(void* const* d_in, const int* in_sizes, int n_in, void* d_out, int out_size, void* d_ws, size_t ws_size, hipStream_t stream) {
    static int grid = 0;
    if (grid == 0) {
        if (n_in != N_IN || in_sizes[0] != M * D || out_size != M * D || ws_size < WS_END) { fprintf(stderr, "kernel_launch: unexpected shapes (n_in %d, in0 %d, out %d, ws %zu)\n", n_in, n_in > 0 ? in_sizes[0] : -1, out_size, ws_size); grid = -1; return; }
        int dev = 0, cus = 0, per_cu = 0;
        (void)hipGetDevice(&dev); (void)hipDeviceGetAttribute(&cus, hipDeviceAttributeMultiprocessorCount, dev);
        (void)hipFuncSetAttribute((const void*)fwd_kernel, hipFuncAttributeMaxDynamicSharedMemorySize, LDS_BYTES);
        (void)hipOccupancyMaxActiveBlocksPerMultiprocessor(&per_cu, (const void*)fwd_kernel, NTHR, LDS_BYTES);
        if (per_cu < 1) { fprintf(stderr, "kernel_launch: occupancy query says %d blocks per CU\n", per_cu); per_cu = 1; }
        (void)hipGetLastError();
        grid = cus;
        if (grid != 256) fprintf(stderr, "kernel_launch: %d CUs; this kernel is written for 256\n", grid);
    }
    if (grid < 0) return;
    Args a{};
    for (int i = 0; i < N_IN; ++i) a.in[i] = (const float*)d_in[i];
    a.out = (float*)d_out; a.ws = (unsigned char*)d_ws; a.ph_lo = 0; a.ph_hi = 11;
    void* kargs[] = {&a};
    hipError_t e = hipLaunchCooperativeKernel((const void*)fwd_kernel, dim3(grid), dim3(NTHR), kargs, LDS_BYTES, stream);
    if (e != hipSuccess) fprintf(stderr, "cooperative launch failed: %s (grid %d)\n", hipGetErrorString(e), grid);
}
```

```cpp
#include <hip/hip_runtime.h>
#include <hip/hip_cooperative_groups.h>
#include <cstdio>
#include <cstdint>
namespace cg = cooperative_groups;
namespace pg8 {
#define PG8_LAS __attribute__((address_space(3)))
typedef unsigned short bf16_t;
typedef short bf16x8 __attribute__((ext_vector_type(8)));
typedef float f32x4 __attribute__((ext_vector_type(4)));
typedef unsigned u32x4 __attribute__((ext_vector_type(4)));
constexpr int BM = 256, BK = 64, HALF = 128, HTB = HALF * BK * 2  , STAGE_BYTES = 8 * HTB, NXCD = 8, WGM = 8;

__host__ __device__ __forceinline__ int lds_byte(int r, int c) { const int st = (r >> 4) * 2 + (c >> 5), rr = r & 15, cc = c & 31, ob = rr * 64 + cc * 2; return st * 1024 + (ob ^ (((ob >> 9) & 1) << 5)); }
__host__ __device__ __forceinline__ void stage_rc(int b, int& R, int& C) { const int st = b / 1024, sb = b % 1024, swz = sb ^ (((sb >> 9) & 1) << 5); R = (st >> 1) * 16 + swz / 64; C = (st & 1) * 32 + (swz % 64) / 2; }
__host__ __device__ __forceinline__ int perm32(int rho) { const int n = rho >> 4, i = rho & 15; return 8 * (i >> 2) + 4 * n + (i & 3); }

struct Unit { int pm, pn; };
struct Gemm { const bf16_t* A; const bf16_t* Bt; int M, N, K; };

struct StaticOrder {
    int nM, nN, nwg, G, c;
    __host__ __device__ void init(int M, int N, int G_, int c_) { nM = M / BM; nN = N / BM; nwg = nM * nN; G = G_; c = c_; }
    __host__ __device__ bool next(int i, Unit& u) const {
        const long L = (long)i * G + c; if (L >= nwg) return false;
        int wgid = (int)L; { const int q = nwg / NXCD, r = nwg % NXCD, xcd = wgid % NXCD, off = wgid / NXCD; wgid = (xcd < r ? xcd * (q + 1) : r * (q + 1) + (xcd - r) * q) + off; }
        const int nig = WGM * nN, gid = wgid / nig, fm = gid * WGM, gsz = (nM - fm) < WGM ? (nM - fm) : WGM;
        u.pm = fm + ((wgid % nig) % gsz); u.pn = (wgid % nig) / gsz; return true;
    }
    __device__ __forceinline__ void a_ready(const Unit&) const {}
    __device__ __forceinline__ void done(const Unit&) const {}
};

__device__ __forceinline__ unsigned cvt_pk_bf16(float lo, float hi) { unsigned r; asm volatile("v_cvt_pk_bf16_f32 %0, %1, %2" : "=v"(r) : "v"(lo), "v"(hi)); return r; }
typedef float f32x2 __attribute__((ext_vector_type(2)));
__device__ __forceinline__ f32x2 gelu_pk(f32x2 v) {
    const f32x2 av = __builtin_elementwise_abs(v), d = av * 0.2316418882f + 1.0f;
    f32x2 t; t.x = __builtin_amdgcn_rcpf(d.x); t.y = __builtin_amdgcn_rcpf(d.y);
    f32x2 q = t * 0.5307027145f + (-0.7265760135f); q = q * t + 0.7107068705f; q = q * t + (-0.142248368f); q = q * t + 0.127414796f; q = q * t;
    const f32x2 s = (v * v) * (-0.72134752044f);
    f32x2 e; e.x = __builtin_amdgcn_exp2f(s.x); e.y = __builtin_amdgcn_exp2f(s.y);
    const f32x2 m = v * (q * e), r = v - m;
    f32x2 o; o.x = v.x < 0.f ? m.x : r.x; o.y = v.y < 0.f ? m.y : r.y; return o;
}

template <int ACT  > struct EpiBf16 {
    static constexpr bool PERM = true, AFTER_DRAIN = false; static_assert(ACT == 0 || ACT == 1, "EpiBf16: ACT is 0 (none) or 1 (gelu_pk)");
    bf16_t* O; int ldc; const float* bias; int split_cols; size_t split_stride; float scale0;
    __device__ __forceinline__ void operator()(const f32x4 (&acc)[2][2][4][2], const Unit& u, int wr, int wc, int fr, int fq) const {
        const int row0 = u.pm * BM + wr * 64 + fr; int colt = u.pn * BM; bf16_t* base = O;
        float sc = 1.f; if (split_cols) { const int t = colt / split_cols; base += (size_t)t * split_stride; colt -= t * split_cols; if (t == 0) sc = scale0; }
        const int col0 = colt + wc * 32 + 8 * fq, bcol0 = u.pn * BM + wc * 32 + 8 * fq;
        f32x4 bv[2][2];
#pragma unroll
        for (int bj = 0; bj < 2; ++bj)
#pragma unroll
            for (int n = 0; n < 2; ++n) bv[bj][n] = bias ? *(const f32x4*)(bias + bcol0 + bj * HALF + 4 * n) : (f32x4){0.f, 0.f, 0.f, 0.f};
#pragma unroll
        for (int ai = 0; ai < 2; ++ai)
#pragma unroll
            for (int m = 0; m < 4; ++m) { bf16_t* rowp = base + (size_t)(row0 + ai * HALF + m * 16) * ldc + col0;
#pragma unroll
                for (int bj = 0; bj < 2; ++bj) { f32x4 v0 = acc[ai][bj][m][0] + bv[bj][0], v1 = acc[ai][bj][m][1] + bv[bj][1];
                    if (ACT == 1) { f32x2 a = gelu_pk((f32x2){v0[0], v0[1]}), b = gelu_pk((f32x2){v0[2], v0[3]}), c = gelu_pk((f32x2){v1[0], v1[1]}), d = gelu_pk((f32x2){v1[2], v1[3]});
                        v0 = (f32x4){a.x, a.y, b.x, b.y}; v1 = (f32x4){c.x, c.y, d.x, d.y}; }
                    v0 = v0 * sc; v1 = v1 * sc; u32x4 w; w.x = cvt_pk_bf16(v0[0], v0[1]); w.y = cvt_pk_bf16(v0[2], v0[3]); w.z = cvt_pk_bf16(v1[0], v1[1]); w.w = cvt_pk_bf16(v1[2], v1[3]);
                    *(u32x4*)(rowp + bj * HALF) = w; } }
    }
};

struct PanelStats {
    unsigned* xbuf;
    unsigned* cnt;
    unsigned* tmo;
    int ntn; float eps;
    unsigned code;
    __device__ __forceinline__ bool run(const f32x4 (&v)[2][2][4][2], const Unit& u, int wr, int wc, int fr, int fq, PG8_LAS unsigned char* lds, int wid, int lane) const {
        typedef float f32x2v __attribute__((ext_vector_type(2)));
        PG8_LAS f32x2v* P = (PG8_LAS f32x2v*)lds;
        PG8_LAS f32x2v* S = (PG8_LAS f32x2v*)(lds + 8192);
        PG8_LAS unsigned* flag = (PG8_LAS unsigned*)(lds + 8192 + 2048);
#pragma unroll
        for (int ai = 0; ai < 2; ++ai)
#pragma unroll
            for (int m = 0; m < 4; ++m) {
                float s = 0.f;
#pragma unroll
                for (int bj = 0; bj < 2; ++bj)
#pragma unroll
                    for (int n = 0; n < 2; ++n) { const f32x4 x = v[ai][bj][m][n]; s += (x[0] + x[1]) + (x[2] + x[3]); }
                s += __shfl_xor(s, 16); s += __shfl_xor(s, 32);
                const float mw = s * (1.0f / 64.0f); float q = 0.f;
#pragma unroll
                for (int bj = 0; bj < 2; ++bj)
#pragma unroll
                    for (int n = 0; n < 2; ++n) { const f32x4 d = v[ai][bj][m][n] - mw; q += (d[0] * d[0] + d[1] * d[1]) + (d[2] * d[2] + d[3] * d[3]); }
                q += __shfl_xor(q, 16); q += __shfl_xor(q, 32);
                if (fq == 0) P[(ai * HALF + wr * 64 + m * 16 + fr) * 4 + wc] = (f32x2v){mw, q};
            }
        asm volatile("s_waitcnt lgkmcnt(0)" ::: "memory"); __builtin_amdgcn_s_barrier(); asm volatile("" ::: "memory");
#if defined(BROKEN_EXCHANGE_NO_WAIT)
#warning BROKEN CONTROL BUILD: the row-statistics exchange does not wait; results are wrong by design
        if (blockIdx.x >= 64) { const long long t0_ = clock64(); while (clock64() - t0_ < 60000) __builtin_amdgcn_s_sleep(8); }
#endif
        const int row = wid * 32 + (lane & 31);
        if (lane < 32) {
            const f32x2v a = P[row * 4 + 0], b = P[row * 4 + 1], c = P[row * 4 + 2], d = P[row * 4 + 3];
            const float mt = (a.x + b.x + c.x + d.x) * 0.25f;
            const float da = a.x - mt, db = b.x - mt, dc = c.x - mt, dd = d.x - mt;
            const float m2 = (a.y + b.y) + (c.y + d.y) + 64.0f * ((da * da + db * db) + (dc * dc + dd * dd));
            unsigned long long* slot = (unsigned long long*)xbuf + ((size_t)(u.pm * BM + row) * 4 + u.pn);
            __hip_atomic_store(slot, ((unsigned long long)__float_as_uint(m2) << 32) | __float_as_uint(mt), __ATOMIC_RELAXED, __HIP_MEMORY_SCOPE_AGENT);
        }
        asm volatile("s_waitcnt vmcnt(0)" ::: "memory");
        if (lane == 0) __hip_atomic_fetch_add(cnt + 64 * u.pm, 1u, __ATOMIC_RELAXED, __HIP_MEMORY_SCOPE_AGENT);
        if (wid == 0) {
            bool dead = false; const unsigned long long t0 = __builtin_amdgcn_s_memrealtime(); const unsigned want = 8u * (unsigned)ntn;
            for (;;) {
#if defined(BROKEN_EXCHANGE_NO_WAIT)
                break;
#endif
                if ((unsigned)__builtin_amdgcn_readfirstlane(__hip_atomic_load(cnt + 64 * u.pm, __ATOMIC_RELAXED, __HIP_MEMORY_SCOPE_AGENT)) >= want) break;
                if (__builtin_amdgcn_s_memrealtime() - t0 > 2000000ull) {
                    if (lane == 0) { unsigned expect = 0u; __hip_atomic_compare_exchange_strong(tmo + 1, &expect, code | (unsigned)(u.pm & 0xff), __ATOMIC_RELAXED, __ATOMIC_RELAXED, __HIP_MEMORY_SCOPE_AGENT);
                                     __hip_atomic_store(tmo, 1u, __ATOMIC_RELAXED, __HIP_MEMORY_SCOPE_AGENT); }
                    dead = true; break; }
                __builtin_amdgcn_s_sleep(2);
            }
            __builtin_amdgcn_fence(__ATOMIC_ACQUIRE, "agent");
            if (lane == 0) flag[0] = dead ? 1u : 0u;
        }
        asm volatile("s_waitcnt vmcnt(0) lgkmcnt(0)" ::: "memory"); __builtin_amdgcn_s_barrier(); asm volatile("" ::: "memory");
        const bool bad = flag[0] != 0u;
        if (lane < 32) {
            const unsigned long long* slot = (const unsigned long long*)xbuf + (size_t)(u.pm * BM + row) * 4; float mt[4], m2[4]; float ms = 0.f;
#pragma unroll
            for (int t = 0; t < 4; ++t) { if (t < ntn) { const unsigned long long w = __hip_atomic_load(slot + t, __ATOMIC_RELAXED, __HIP_MEMORY_SCOPE_AGENT); mt[t] = __uint_as_float((unsigned)w); m2[t] = __uint_as_float((unsigned)(w >> 32)); } else { mt[t] = 0.f; m2[t] = 0.f; } ms += mt[t]; }
            const float mean = ms / (float)ntn; float q = 0.f;
#pragma unroll
            for (int t = 0; t < 4; ++t) if (t < ntn) { const float dm = mt[t] - mean; q += m2[t] + 256.0f * dm * dm; }
            S[row] = (f32x2v){mean, 1.0f / sqrtf(q / (256.0f * (float)ntn) + eps)};
        }
        asm volatile("s_waitcnt lgkmcnt(0)" ::: "memory"); __builtin_amdgcn_s_barrier(); asm volatile("" ::: "memory");
        return bad;
    }
};
struct EpiLnRes {
    static constexpr bool PERM = false, AFTER_DRAIN = true;
    const float* base; float* out; int ldc; const float* bias; PanelStats st; unsigned poison;
    __device__ __forceinline__ void fused(f32x4 (&acc)[2][2][4][2], const Unit& u, int wr, int wc, int fr, int fq, PG8_LAS unsigned char* lds, int wid, int lane) const {
        typedef float f32x2v __attribute__((ext_vector_type(2)));
        const PG8_LAS f32x2v* S = (const PG8_LAS f32x2v*)(lds + 8192);
        const int col0 = u.pn * BM + wc * 32 + 4 * fq;
#pragma unroll
        for (int bj = 0; bj < 2; ++bj)
#pragma unroll
            for (int n = 0; n < 2; ++n) { const f32x4 bv = bias ? *(const f32x4*)(bias + col0 + bj * HALF + n * 16) : (f32x4){0.f, 0.f, 0.f, 0.f};
#pragma unroll
                for (int ai = 0; ai < 2; ++ai)
#pragma unroll
                    for (int m = 0; m < 4; ++m) acc[ai][bj][m][n] += bv; }
        f32x4 pre[4][2][2];
#pragma unroll
        for (int m = 0; m < 4; ++m) { const size_t off = (size_t)(u.pm * BM + wr * 64 + m * 16 + fr) * ldc + col0;
#pragma unroll
            for (int bj = 0; bj < 2; ++bj)
#pragma unroll
                for (int n = 0; n < 2; ++n) pre[m][bj][n] = *(const f32x4*)(base + off + bj * HALF + n * 16); }
        const bool bad = st.run(acc, u, wr, wc, fr, fq, lds, wid, lane) || poison != 0u;
        const float qnan = __builtin_nanf("");
#pragma unroll
        for (int ai = 0; ai < 2; ++ai)
#pragma unroll
            for (int m = 0; m < 4; ++m) { const int r = ai * HALF + wr * 64 + m * 16 + fr; const f32x2v sr = S[r]; const size_t off = (size_t)(u.pm * BM + r) * ldc + col0;
#pragma unroll
                for (int bj = 0; bj < 2; ++bj)
#pragma unroll
                    for (int n = 0; n < 2; ++n) { const f32x4 bs = ai == 0 ? pre[m][bj][n] : *(const f32x4*)(base + off + bj * HALF + n * 16); f32x4 o = bs + (acc[ai][bj][m][n] - sr.x) * sr.y;
                        if (bad) o = (f32x4){qnan, qnan, qnan, qnan}; *(f32x4*)(out + off + bj * HALF + n * 16) = o; }
                if (m & 1) asm volatile("" ::: "memory"); }
    }
};
struct EpiLnResLn {
    static constexpr bool PERM = false, AFTER_DRAIN = true;
    const float* base; float* out; bf16_t* xn; int ldc; const float* bias; PanelStats st1, st2; unsigned poison;
    __device__ __forceinline__ void fused(f32x4 (&acc)[2][2][4][2], const Unit& u, int wr, int wc, int fr, int fq, PG8_LAS unsigned char* lds, int wid, int lane) const {
        typedef float f32x2v __attribute__((ext_vector_type(2))); typedef unsigned u32x2v __attribute__((ext_vector_type(2)));
        const PG8_LAS f32x2v* S = (const PG8_LAS f32x2v*)(lds + 8192);
        const int col0 = u.pn * BM + wc * 32 + 4 * fq;
#pragma unroll
        for (int bj = 0; bj < 2; ++bj)
#pragma unroll
            for (int n = 0; n < 2; ++n) { const f32x4 bv = bias ? *(const f32x4*)(bias + col0 + bj * HALF + n * 16) : (f32x4){0.f, 0.f, 0.f, 0.f};
#pragma unroll
                for (int ai = 0; ai < 2; ++ai)
#pragma unroll
                    for (int m = 0; m < 4; ++m) acc[ai][bj][m][n] += bv; }
        bool bad = st1.run(acc, u, wr, wc, fr, fq, lds, wid, lane) || poison != 0u;
        const float qnan = __builtin_nanf("");
#pragma unroll
        for (int ai = 0; ai < 2; ++ai)
#pragma unroll
            for (int m = 0; m < 4; ++m) { const int r = ai * HALF + wr * 64 + m * 16 + fr; const f32x2v sr = S[r]; const size_t off = (size_t)(u.pm * BM + r) * ldc + col0;
#pragma unroll
                for (int bj = 0; bj < 2; ++bj)
#pragma unroll
                    for (int n = 0; n < 2; ++n) { const f32x4 bs = *(const f32x4*)(base + off + bj * HALF + n * 16); acc[ai][bj][m][n] = bs + (acc[ai][bj][m][n] - sr.x) * sr.y; }
                asm volatile("" : "+v"(acc[ai][0][m][0]), "+v"(acc[ai][0][m][1]), "+v"(acc[ai][1][m][0]), "+v"(acc[ai][1][m][1]));
                if (m & 1) asm volatile("" ::: "memory"); }
        const bool bad1 = bad;
        bad = st2.run(acc, u, wr, wc, fr, fq, lds, wid, lane) || bad;
#pragma unroll
        for (int ai = 0; ai < 2; ++ai)
#pragma unroll
            for (int m = 0; m < 4; ++m) { const int r = ai * HALF + wr * 64 + m * 16 + fr; const f32x2v sr = S[r]; const size_t off = (size_t)(u.pm * BM + r) * ldc + col0;
#pragma unroll
                for (int bj = 0; bj < 2; ++bj)
#pragma unroll
                    for (int n = 0; n < 2; ++n) { const f32x4 x1 = acc[ai][bj][m][n]; *(f32x4*)(out + off + bj * HALF + n * 16) = bad1 ? (f32x4){qnan, qnan, qnan, qnan} : x1;
                        const f32x4 o = (x1 - sr.x) * sr.y; u32x2v w; w.x = cvt_pk_bf16(o[0], o[1]); w.y = cvt_pk_bf16(o[2], o[3]);
                        if (bad) { w.x = 0x7fc07fc0u; w.y = 0x7fc07fc0u; } *(u32x2v*)(xn + off + bj * HALF + n * 16) = w; }
                asm volatile("" ::: "memory"); }
    }
};

template <class Epi, class Sched, bool ALIGN_EPI = false, bool SP2 = false>
__device__ __forceinline__ void gemm_phase(PG8_LAS unsigned char* lds, const Gemm g, const Sched& S, const Epi& E) {
    const int tid = threadIdx.x, wid = __builtin_amdgcn_readfirstlane(tid >> 6), lane = tid & 63, wr = wid >> 2, wc = wid & 3, fr = lane & 15, fq = lane >> 4;
    const int K = g.K, nt = K / BK;
    unsigned voffA[2], voffB[2];
#pragma unroll
    for (int i = 0; i < 2; ++i) { int R, C; stage_rc(tid * 16 + i * 8192, R, C); const int Rb = Epi::PERM ? ((R & ~31) + perm32(R & 31)) : R;
        voffA[i] = (unsigned)(R * K + C) * 2u; voffB[i] = (unsigned)(Rb * K + C) * 2u; }
    const size_t kstep = (size_t)(BK * 2);
    const size_t hstep = (size_t)HALF * K * 2;
    const size_t tstep = 2 * hstep;
    const unsigned ldsw = (unsigned)wid * 1024u;
    const int aoff = lds_byte(wr * 64 + fr, fq * 8), boff = lds_byte(wc * 32 + fr, fq * 8);
#define PG8_SA(b, h) (((b) * 2 + (h)) * HTB)
#define PG8_SB(b, h) ((4 + (b) * 2 + (h)) * HTB)
#define PG8_STAGE(bufoff, gbase, voff) do { _Pragma("unroll") for (int _i = 0; _i < 2; ++_i) \
        __builtin_amdgcn_global_load_lds((const unsigned*)((const char*)(gbase) + (voff)[_i]), (PG8_LAS unsigned*)(lds + (bufoff) + ldsw + _i * 8192), 16, 0, 0); } while (0)
#define PG8_LDA(dst, b, h) do { _Pragma("unroll") for (int m = 0; m < 4; ++m) _Pragma("unroll") for (int k = 0; k < 2; ++k) dst[m][k] = *(const PG8_LAS bf16x8*)(lds + PG8_SA(b, h) + aoff + m * 2048 + k * 1024); } while (0)
#define PG8_LDB(dst, b, h) do { _Pragma("unroll") for (int n = 0; n < 2; ++n) _Pragma("unroll") for (int k = 0; k < 2; ++k) dst[n][k] = *(const PG8_LAS bf16x8*)(lds + PG8_SB(b, h) + boff + n * 2048 + k * 1024); } while (0)
#define PG8_MMA(ai, bj, At, Bt) do { __builtin_amdgcn_s_setprio(1); _Pragma("unroll") for (int m = 0; m < 4; ++m) _Pragma("unroll") for (int n = 0; n < 2; ++n) _Pragma("unroll") for (int k = 0; k < 2; ++k) \
        acc[ai][bj][m][n] = __builtin_amdgcn_mfma_f32_16x16x32_bf16(Bt[n][k], At[m][k], acc[ai][bj][m][n], 0, 0, 0); __builtin_amdgcn_s_setprio(0); } while (0)
#define PG8_WAIT_V(n) asm volatile("s_waitcnt vmcnt(" #n ")" ::: "memory")
#define PG8_WAIT_L(n) asm volatile("s_waitcnt lgkmcnt(" #n ")" ::: "memory")
#define PG8_BAR __builtin_amdgcn_s_barrier()
#define PG8_SCHED __builtin_amdgcn_sched_barrier(0)
    Unit cur, nxt; int ui = 0;
    if (!S.next(0, cur)) return;
    f32x4 acc[2][2][4][2];
#pragma unroll
    for (int a = 0; a < 2; ++a)
#pragma unroll
        for (int b = 0; b < 2; ++b)
#pragma unroll
            for (int m = 0; m < 4; ++m)
#pragma unroll
                for (int n = 0; n < 2; ++n) acc[a][b][m][n] = (f32x4){0.f, 0.f, 0.f, 0.f};
    bf16x8 At[4][2], B0[2][2], B1[2][2];
    const char* cA = (const char*)g.A + (size_t)cur.pm * tstep; const char* cB = (const char*)g.Bt + (size_t)cur.pn * tstep;
    S.a_ready(cur);
    if constexpr (SP2) {
        PG8_STAGE(PG8_SB(0, 0), cB, voffB); PG8_STAGE(PG8_SB(0, 1), cB + hstep, voffB); PG8_STAGE(PG8_SA(0, 0), cA, voffA); PG8_STAGE(PG8_SA(0, 1), cA + hstep, voffA);
        if (wr == 1) PG8_BAR;
        PG8_WAIT_V(2); PG8_BAR;
        PG8_STAGE(PG8_SB(1, 0), cB + kstep, voffB); PG8_STAGE(PG8_SA(1, 0), cA + kstep, voffA); PG8_STAGE(PG8_SB(1, 1), cB + hstep + kstep, voffB);
        PG8_WAIT_V(6); PG8_BAR;
    } else {
        PG8_STAGE(PG8_SB(0, 0), cB, voffB); PG8_STAGE(PG8_SA(0, 0), cA, voffA); PG8_STAGE(PG8_SB(0, 1), cB + hstep, voffB); PG8_STAGE(PG8_SA(0, 1), cA + hstep, voffA);
        if (wr == 1) PG8_BAR;
        PG8_WAIT_V(4); PG8_BAR;
        PG8_STAGE(PG8_SB(1, 0), cB + kstep, voffB); PG8_STAGE(PG8_SA(1, 0), cA + kstep, voffA); PG8_STAGE(PG8_SB(1, 1), cB + hstep + kstep, voffB);
        PG8_WAIT_V(6); PG8_BAR;
    }
    for (;;) {
        const bool has_next = S.next(ui + 1, nxt);
        const char* nA = has_next ? (const char*)g.A + (size_t)nxt.pm * tstep : cA; const char* nB = has_next ? (const char*)g.Bt + (size_t)nxt.pn * tstep : cB;
        for (int t = 0; t < nt; t += 2) {
            const bool last = (t == nt - 2);
            const char* a1 = cA + (size_t)(t + 1) * kstep;
            const char* a2 = last ? nA : cA + (size_t)(t + 2) * kstep; const char* b2 = last ? nB : cB + (size_t)(t + 2) * kstep;
            const char* a3 = a2 + kstep; const char* b3 = b2 + kstep;
            if (last && has_next) S.a_ready(nxt);
            if constexpr (SP2) {
            PG8_LDB(B0, 0, 0); PG8_LDB(B1, 0, 1); PG8_SCHED; PG8_LDA(At, 0, 0); PG8_STAGE(PG8_SA(1, 1), a1 + hstep, voffA);
            PG8_WAIT_V(8); PG8_WAIT_L(0); PG8_BAR; PG8_MMA(0, 0, At, B0); PG8_MMA(0, 1, At, B1); PG8_BAR; PG8_SCHED;
            PG8_LDA(At, 0, 1); PG8_STAGE(PG8_SB(0, 0), b2, voffB); PG8_STAGE(PG8_SB(0, 1), b2 + hstep, voffB); PG8_STAGE(PG8_SA(0, 0), a2, voffA);
            PG8_WAIT_V(8); PG8_WAIT_L(0); PG8_BAR; PG8_MMA(1, 0, At, B0); PG8_MMA(1, 1, At, B1); PG8_BAR; PG8_SCHED;
            PG8_LDB(B0, 1, 0); PG8_LDB(B1, 1, 1); PG8_SCHED; PG8_LDA(At, 1, 0); PG8_STAGE(PG8_SA(0, 1), a2 + hstep, voffA);
            PG8_WAIT_V(8); PG8_WAIT_L(0); PG8_BAR; PG8_MMA(0, 0, At, B0); PG8_MMA(0, 1, At, B1); PG8_BAR; PG8_SCHED;
            PG8_LDA(At, 1, 1); PG8_STAGE(PG8_SB(1, 0), b3, voffB); PG8_STAGE(PG8_SB(1, 1), b3 + hstep, voffB); PG8_STAGE(PG8_SA(1, 0), a3, voffA);
            PG8_WAIT_V(8); PG8_WAIT_L(0); PG8_BAR; PG8_MMA(1, 0, At, B0); PG8_MMA(1, 1, At, B1); PG8_BAR; PG8_SCHED;
            } else {
            PG8_LDB(B0, 0, 0); PG8_SCHED; PG8_LDA(At, 0, 0); PG8_STAGE(PG8_SA(1, 1), a1 + hstep, voffA);
            PG8_WAIT_L(8); PG8_BAR; PG8_WAIT_L(0); PG8_MMA(0, 0, At, B0); PG8_BAR; PG8_SCHED;
            PG8_LDB(B1, 0, 1); PG8_STAGE(PG8_SB(0, 0), b2, voffB);
            PG8_BAR; PG8_WAIT_L(0); PG8_MMA(0, 1, At, B1); PG8_BAR;
            PG8_LDA(At, 0, 1); PG8_STAGE(PG8_SA(0, 0), a2, voffA);
            PG8_BAR; PG8_WAIT_L(0); PG8_MMA(1, 0, At, B0); PG8_BAR; PG8_SCHED;
            PG8_STAGE(PG8_SB(0, 1), b2 + hstep, voffB);
            PG8_WAIT_V(6); PG8_BAR; PG8_MMA(1, 1, At, B1); PG8_BAR;
            PG8_LDB(B0, 1, 0); PG8_SCHED; PG8_LDA(At, 1, 0); PG8_STAGE(PG8_SA(0, 1), a2 + hstep, voffA);
            PG8_WAIT_L(8); PG8_BAR; PG8_WAIT_L(0); PG8_MMA(0, 0, At, B0); PG8_BAR; PG8_SCHED;
            PG8_LDB(B1, 1, 1); PG8_STAGE(PG8_SB(1, 0), b3, voffB);
            PG8_BAR; PG8_WAIT_L(0); PG8_MMA(0, 1, At, B1); PG8_BAR;
            PG8_LDA(At, 1, 1); PG8_STAGE(PG8_SA(1, 0), a3, voffA);
            PG8_BAR; PG8_WAIT_L(0); PG8_MMA(1, 0, At, B0); PG8_BAR; PG8_SCHED;
            PG8_STAGE(PG8_SB(1, 1), b3 + hstep, voffB);
            PG8_WAIT_V(6); PG8_BAR; PG8_MMA(1, 1, At, B1); PG8_BAR;
            }
        }
        if constexpr (ALIGN_EPI) { if (wr == 0) PG8_BAR; }
        if constexpr (!Epi::AFTER_DRAIN) { E(acc, cur, wr, wc, fr, fq); S.done(cur); }
        if (!has_next) break;
#pragma unroll
        for (int a = 0; a < 2; ++a)
#pragma unroll
            for (int b = 0; b < 2; ++b)
#pragma unroll
                for (int m = 0; m < 4; ++m)
#pragma unroll
                    for (int n = 0; n < 2; ++n) acc[a][b][m][n] = (f32x4){0.f, 0.f, 0.f, 0.f};
        cur = nxt; cA = nA; cB = nB; ++ui;
        if constexpr (ALIGN_EPI) { if (wr == 1) PG8_BAR; }
    }
    PG8_WAIT_V(0);
    if constexpr (!ALIGN_EPI) { if (wr == 0) PG8_BAR; }
    PG8_BAR;
    if constexpr (Epi::AFTER_DRAIN) { E.fused(acc, cur, wr, wc, fr, fq, lds, wid, lane); S.done(cur); }
#undef PG8_SA
#undef PG8_SB
#undef PG8_STAGE
#undef PG8_LDA
#undef PG8_LDB
#undef PG8_MMA
#undef PG8_WAIT_V
#undef PG8_WAIT_L
#undef PG8_BAR
#undef PG8_SCHED
}
}

#define LAS __attribute__((address_space(3)))
typedef unsigned short bf16;
typedef float f32x4 __attribute__((ext_vector_type(4)));
typedef float f32x2 __attribute__((ext_vector_type(2)));
typedef short bf16x8 __attribute__((ext_vector_type(8)));
typedef unsigned u32x4 __attribute__((ext_vector_type(4)));
typedef unsigned u32x2 __attribute__((ext_vector_type(2)));
typedef _Float16 f16x4 __attribute__((ext_vector_type(4)));

constexpr int NB = 16, T = 2048, D = 1024, M = NB * T;
constexpr int NIN = 2848, PP = 3072;
constexpr int HID = 2816, NFF = 5632;
constexpr float ALPHA = 1.189207115002721f;
constexpr float LN_EPS = 1e-5f, GN_EPS = 64e-5f;
constexpr int NWAVES = 8, NTHR = 512;
constexpr int LDS_BYTES = 147456;

constexpr size_t MiB = 1u << 20;
constexpr size_t WS_MOD = 1 * MiB, WS_STATS = WS_MOD + 512 * 1024, WS_RK = 2 * MiB;
constexpr size_t WS_WUP = 3 * MiB, WS_AUP = WS_WUP + 65536, WS_GUP = WS_AUP + 65536;
constexpr size_t WS_WIN = 4 * MiB, WS_WOUT = 10 * MiB, WS_WFFI = 12 * MiB, WS_WFFO = 23 * MiB;
constexpr size_t WS_H = 32 * MiB, WS_P = 96 * MiB, WS_E = 288 * MiB, WS_A = 320 * MiB, WS_G = 352 * MiB, WS_YRAW = 384 * MiB, WS_Y = 448 * MiB, WS_END = 512 * MiB;
constexpr size_t WS_X1 = 288 * MiB;
constexpr size_t WS_HID = 96 * MiB;

enum { I_X = 0, I_C, I_EG, I_EB, I_WADA, I_BADA, I_WIN, I_MU, I_SGG, I_SGB, I_WS, I_BS, I_W0, I_WUP, I_A0, I_AUP, I_GUP, I_KK, I_KA, I_RK, I_LXG, I_LXB, I_WOUT, I_L1G, I_L1B, I_WFFI, I_WFFO, I_L2G, I_L2B, N_IN };

__device__ __forceinline__ unsigned f2bf(float f) { unsigned u = __builtin_bit_cast(unsigned, f); return (u + 0x7fffu + ((u >> 16) & 1u)) >> 16; }
__device__ __forceinline__ unsigned pk2(float lo, float hi) { return f2bf(lo) | (f2bf(hi) << 16); }
__device__ __forceinline__ u32x2 pk4(f32x4 v) { u32x2 r; r.x = pk2(v.x, v.y); r.y = pk2(v.z, v.w); return r; }
__device__ __forceinline__ f32x4 unpk4(u32x2 u) { f32x4 r; r.x = __uint_as_float(u.x << 16); r.y = __uint_as_float(u.x & 0xffff0000u); r.z = __uint_as_float(u.y << 16); r.w = __uint_as_float(u.y & 0xffff0000u); return r; }
__device__ __forceinline__ float bf_lo(unsigned u) { return __uint_as_float(u << 16); }
__device__ __forceinline__ float bf_hi(unsigned u) { return __uint_as_float(u & 0xffff0000u); }
__device__ __forceinline__ float sigmoidf_(float x) { return __builtin_amdgcn_rcpf(1.0f + __builtin_amdgcn_exp2f(-1.4426950408889634f * x)); }
__device__ __forceinline__ float gelu_tanh(float x) { return x * __builtin_amdgcn_rcpf(1.0f + __builtin_amdgcn_exp2f(-2.302208198f * x * (1.0f + 0.044715f * x * x))); }
#define LDS_WAIT() asm volatile("s_waitcnt lgkmcnt(0)" ::: "memory")

template <int CTRL> __device__ __forceinline__ float dppx(float x) { return __int_as_float(__builtin_amdgcn_update_dpp(0, __float_as_int(x), CTRL, 0xf, 0xf, true)); }
__device__ __forceinline__ float reduce4(float x) { x += dppx<0xB1>(x); x += dppx<0x4E>(x); return x; }
__device__ __forceinline__ float reduce16(float x) { x += dppx<0xB1>(x); x += dppx<0x4E>(x); x += dppx<0x141>(x); x += dppx<0x140>(x); return x; }
__device__ __forceinline__ float wave_sum(float v) {
#pragma unroll
    for (int o = 1; o < 64; o <<= 1) v += __shfl_xor(v, o);
    return v;
}

namespace pg8 {
struct EpiP {
    static constexpr bool PERM = true, AFTER_DRAIN = false;
    bf16_t* O;
    __device__ __forceinline__ void operator()(const f32x4 (&acc)[2][2][4][2], const Unit& u, int wr, int wc, int fr, int fq) const {
        const int row0 = u.pm * BM + wr * 64 + fr, col0 = u.pn * BM + wc * 32 + 8 * fq; const bool act = u.pn < 4;
#pragma unroll
        for (int ai = 0; ai < 2; ++ai)
#pragma unroll
            for (int m = 0; m < 4; ++m) { bf16_t* rowp = O + (size_t)(row0 + ai * HALF + m * 16) * PP + col0;
#pragma unroll
                for (int bj = 0; bj < 2; ++bj) { f32x4 v0 = acc[ai][bj][m][0], v1 = acc[ai][bj][m][1];
                    if (act) {
#pragma unroll
                        for (int e = 0; e < 4; ++e) { v0[e] = gelu_tanh(v0[e]); v1[e] = gelu_tanh(v1[e]); } }
                    u32x4 w; w.x = cvt_pk_bf16(v0[0], v0[1]); w.y = cvt_pk_bf16(v0[2], v0[3]); w.z = cvt_pk_bf16(v1[0], v1[1]); w.w = cvt_pk_bf16(v1[2], v1[3]);
                    *(u32x4*)(rowp + bj * HALF) = w; } }
    }
};
struct EpiZ1 {
    static constexpr bool PERM = false, AFTER_DRAIN = false;
    const float* x; const float* stats; const float* eg; const float* eb; const float* mod; float* out;
    __device__ __forceinline__ void operator()(const f32x4 (&acc)[2][2][4][2], const Unit& u, int wr, int wc, int fr, int fq) const {
        const int b = u.pm >> 3, col0 = u.pn * BM + wc * 32 + 4 * fq;
#pragma unroll
        for (int bj = 0; bj < 2; ++bj)
#pragma unroll
            for (int n = 0; n < 2; ++n) { const int c = col0 + bj * HALF + n * 16;
                const f32x4 g4 = *(const f32x4*)(eg + c), b4 = *(const f32x4*)(eb + c), gt = *(const f32x4*)(mod + b * 6144 + 2048 + c);
#pragma unroll
                for (int ai = 0; ai < 2; ++ai)
#pragma unroll
                    for (int m = 0; m < 4; ++m) { const int r = u.pm * BM + ai * HALF + wr * 64 + m * 16 + fr; const f32x2 st = *(const f32x2*)(stats + 2 * r);
                        const size_t off = (size_t)r * D + c; const f32x4 xv = *(const f32x4*)(x + off);
                        const f32x4 x0 = (xv - st.x) * st.y * g4 + b4;
                        *(f32x4*)(out + off) = x0 * ALPHA + gt * acc[ai][bj][m][n]; } }
    }
};
struct EpiHid {
    static constexpr bool PERM = true, AFTER_DRAIN = false;
    bf16_t* O;
    __device__ __forceinline__ void operator()(const f32x4 (&acc)[2][2][4][2], const Unit& u, int wr, int wc, int fr, int fq) const {
        const int row0 = u.pm * BM + wr * 64 + fr, col0 = u.pn * HALF + wc * 32 + 8 * fq;
#pragma unroll
        for (int ai = 0; ai < 2; ++ai)
#pragma unroll
            for (int m = 0; m < 4; ++m) { bf16_t* rowp = O + (size_t)(row0 + ai * HALF + m * 16) * HID + col0;
                f32x4 h0, h1;
#pragma unroll
                for (int e = 0; e < 4; ++e) { const float g0 = acc[ai][0][m][0][e], g1 = acc[ai][0][m][1][e];
                    h0[e] = g0 * sigmoidf_(g0) * acc[ai][1][m][0][e]; h1[e] = g1 * sigmoidf_(g1) * acc[ai][1][m][1][e]; }
                u32x4 w; w.x = cvt_pk_bf16(h0[0], h0[1]); w.y = cvt_pk_bf16(h0[2], h0[3]); w.z = cvt_pk_bf16(h1[0], h1[1]); w.w = cvt_pk_bf16(h1[2], h1[3]);
                *(u32x4*)rowp = w; }
    }
};
struct EpiZ2 {
    static constexpr bool PERM = false, AFTER_DRAIN = false;
    const float* x1; const float* mod; float* out;
    __device__ __forceinline__ void operator()(const f32x4 (&acc)[2][2][4][2], const Unit& u, int wr, int wc, int fr, int fq) const {
        const int b = u.pm >> 3, col0 = u.pn * BM + wc * 32 + 4 * fq;
#pragma unroll
        for (int bj = 0; bj < 2; ++bj)
#pragma unroll
            for (int n = 0; n < 2; ++n) { const int c = col0 + bj * HALF + n * 16; const f32x4 gt = *(const f32x4*)(mod + b * 6144 + 5120 + c);
#pragma unroll
                for (int ai = 0; ai < 2; ++ai)
#pragma unroll
                    for (int m = 0; m < 4; ++m) { const int r = u.pm * BM + ai * HALF + wr * 64 + m * 16 + fr; const size_t off = (size_t)r * D + c;
                        *(f32x4*)(out + off) = *(const f32x4*)(x1 + off) * ALPHA + gt * acc[ai][bj][m][n]; } }
    }
};
}


__device__ __forceinline__ unsigned long long rt() { return __builtin_amdgcn_s_memrealtime(); }
#define XB_TMO      128
#define XB_XCNT(j)  (256  + 64 * (j))
#define XB_XSUB(j)  (1280 + 64 * (j))
#define XB_XGEN(j)  (2304 + 64 * (j))
#define XB_TOP      3328
#define XB_TOPGEN   3392
#define XCD_BAR_WORDS 3456
#define XB_SPIN_CAP (1u << 18)

__device__ __forceinline__ unsigned xb_ld(unsigned* p)              { return __hip_atomic_load(p, __ATOMIC_RELAXED, __HIP_MEMORY_SCOPE_AGENT); }
__device__ __forceinline__ unsigned xb_add(unsigned* p, unsigned v) { return __hip_atomic_fetch_add(p, v, __ATOMIC_RELAXED, __HIP_MEMORY_SCOPE_AGENT); }
__device__ __forceinline__ unsigned xb_xcc_id() { return (unsigned)__builtin_amdgcn_s_getreg((3 << 11) | 20) & 0xFu; }
#define XB_SPIN(cond, bar) do { unsigned _sp = 0; while (cond) { __builtin_amdgcn_s_sleep(1); \
    if ((++_sp & 255u) == 0u) { if (xb_ld(&(bar)[XB_TMO])) break; if (_sp > XB_SPIN_CAP) { atomicAdd(&(bar)[XB_TMO], 1u); break; } } } } while (0)

struct XcdBarrier {
    unsigned* bar; unsigned x;
    volatile LAS unsigned* st;
};

__device__ __forceinline__ XcdBarrier xcd_barrier_post(unsigned* bar, volatile LAS unsigned* st) {
    XcdBarrier b; b.bar = bar; b.x = xb_xcc_id(); b.st = st;
    if (threadIdx.x == 0) (void)xb_add(&bar[XB_XCNT(b.x)], 1u);
    return b;
}
__device__ __forceinline__ void xcd_barrier_complete(unsigned* bar, unsigned x, unsigned& nloc, unsigned& nx) {
    const unsigned G = gridDim.x * gridDim.y * gridDim.z;
    unsigned sum, cnt, mine, sp = 0u;
    for (;;) {
        sum = 0u; cnt = 0u; mine = 0u;
#pragma unroll
        for (unsigned j = 0; j < 16; ++j) { const unsigned c = xb_ld(&bar[XB_XCNT(j)]); sum += c; cnt += (c > 0u) ? 1u : 0u; mine = (j == x) ? c : mine; }
        if (sum == G) break;
        __builtin_amdgcn_s_sleep(1);
        if ((++sp & 255u) == 0u) { if (xb_ld(&bar[XB_TMO])) break; if (sp > XB_SPIN_CAP) { atomicAdd(&bar[XB_TMO], 1u); break; } }
    }
    nloc = mine > 0u ? mine : 1u; nx = cnt > 0u ? cnt : 1u;
}

__device__ __forceinline__ void xcd_barrier(const XcdBarrier& b) {
    asm volatile("s_waitcnt vmcnt(0)" ::: "memory");
    __syncthreads();
    if (threadIdx.x == 0) {
        unsigned* bar = b.bar;
        __builtin_amdgcn_s_waitcnt(0);
        unsigned nloc = b.st[0], nx = b.st[1];
        if (nloc == 0u) { xcd_barrier_complete(bar, b.x, nloc, nx); b.st[0] = nloc; b.st[1] = nx; }
        const unsigned old = xb_add(&bar[XB_XSUB(b.x)], 1u);
        const unsigned gen = old / nloc;
        if (old + 1u == (gen + 1u) * nloc) {
            __builtin_amdgcn_fence(__ATOMIC_RELEASE, "agent");
            asm volatile("s_waitcnt vmcnt(0)" ::: "memory");
            const unsigned og = xb_add(&bar[XB_TOP], 1u);
            const unsigned tg = og / nx;
            if (og + 1u == (tg + 1u) * nx) xb_add(&bar[XB_TOPGEN], 1u);
            else XB_SPIN(xb_ld(&bar[XB_TOPGEN]) == tg, bar);
            __builtin_amdgcn_fence(__ATOMIC_ACQUIRE, "agent");
            xb_add(&bar[XB_XGEN(b.x)], 1u);
            asm volatile("s_waitcnt vmcnt(0)" ::: "memory");
        } else {
            XB_SPIN(xb_ld(&bar[XB_XGEN(b.x)]) == gen, bar);
            __builtin_amdgcn_fence(__ATOMIC_ACQUIRE, "agent");
            asm volatile("s_waitcnt vmcnt(0)" ::: "memory");
        }
    }
    __syncthreads();
}

#ifndef DUP_MASK
#define DUP_MASK 0
#endif
struct Args { const float* in[N_IN]; float* out; unsigned char* ws; int ph_lo, ph_hi; };
static_assert(sizeof(Args) == (N_IN + 2) * 8 + 8, "Args has no padding");

__device__ __forceinline__ void transpose_item(const float* W, int K, int N, bf16* WT, int k0, int n0, int dst_row0, LAS float* scr, int lane) {
#pragma unroll 8
    for (int i = 0; i < 32; ++i) { const int kk = 2 * i + (lane >> 5); scr[kk * 33 + (lane & 31)] = W[(size_t)(k0 + kk) * N + n0 + (lane & 31)]; }
    LDS_WAIT(); asm volatile("" ::: "memory");
    const int c = lane & 7;
#pragma unroll
    for (int j = 0; j < 4; ++j) { const int n = (lane >> 3) + 8 * j; const LAS float* s = scr + (8 * c) * 33 + n;
        u32x4 o; o.x = pk2(s[0 * 33], s[1 * 33]); o.y = pk2(s[2 * 33], s[3 * 33]); o.z = pk2(s[4 * 33], s[5 * 33]); o.w = pk2(s[6 * 33], s[7 * 33]);
        *(u32x4*)(WT + (size_t)(dst_row0 + n) * K + k0 + 8 * c) = o; }
    LDS_WAIT(); asm volatile("" ::: "memory");
}

__device__ __forceinline__ void p0_prologue(const Args& a, LAS unsigned char* lds, int tid, int lane, int wave, int vcu, int G) {
    unsigned char* ws = a.ws;
    if (blockIdx.x < 96) {
        const int col0 = blockIdx.x * 64;
        LAS float* sc = (LAS float*)(lds + 65536 + wave * 8192);
        const float* c = a.in[I_C];
        for (int i = 0; i < 32; ++i) { const int idx = i * 64 + lane, b = idx >> 7, k = idx & 127; const float cv = c[b * 1024 + 128 * wave + k]; sc[idx] = cv * sigmoidf_(cv); }
        LDS_WAIT(); asm volatile("" ::: "memory");
        float acc[16];
#pragma unroll
        for (int b = 0; b < 16; ++b) acc[b] = 0.f;
        const float* W = a.in[I_WADA] + (size_t)(128 * wave) * 6144 + col0 + lane;
        for (int k4 = 0; k4 < 32; ++k4) {
            const float w0 = W[(size_t)(4 * k4 + 0) * 6144], w1 = W[(size_t)(4 * k4 + 1) * 6144], w2 = W[(size_t)(4 * k4 + 2) * 6144], w3 = W[(size_t)(4 * k4 + 3) * 6144];
#pragma unroll
            for (int b = 0; b < 16; ++b) { const f32x4 s4 = *(const LAS f32x4*)(sc + b * 128 + 4 * k4); acc[b] += s4.x * w0 + s4.y * w1 + s4.z * w2 + s4.w * w3; }
        }
        LAS float* red = (LAS float*)lds;
#pragma unroll
        for (int b = 0; b < 16; ++b) red[(wave * 16 + b) * 64 + lane] = acc[b];
        __syncthreads();
        float* mod = (float*)(ws + WS_MOD);
        for (int o = tid; o < 1024; o += NTHR) { const int b = o >> 6, l = o & 63; float s = a.in[I_BADA][col0 + l];
#pragma unroll
            for (int w = 0; w < 8; ++w) s += red[(w * 16 + b) * 64 + l];
            mod[b * 6144 + col0 + l] = s; }
        __syncthreads();
    }
    LAS float* scr = (LAS float*)(lds + wave * 16384);
    const int gw = vcu * NWAVES + wave, NGW = G * NWAVES;
    constexpr int NB_IN = NIN / 32, I_IN = 16 * NB_IN, I_OUT = 16 * 32, NB_FFI = NFF / 32, I_FFI = 16 * NB_FFI, I_FFO = (HID / 64) * 32;
    constexpr int NITEMS = I_IN + I_OUT + I_FFI + I_FFO;
    bf16* Win = (bf16*)(ws + WS_WIN); bf16* Wout = (bf16*)(ws + WS_WOUT); bf16* Wffi = (bf16*)(ws + WS_WFFI); bf16* Wffo = (bf16*)(ws + WS_WFFO);
    for (int it = gw; it < NITEMS; it += NGW) {
        int r = it;
        if (r < I_IN) { const int kb = r / NB_IN, nb = r % NB_IN; transpose_item(a.in[I_WIN], D, NIN, Win, 64 * kb, 32 * nb, 32 * nb, scr, lane); continue; } r -= I_IN;
        if (r < I_OUT) { const int kb = r / 32, nb = r % 32; transpose_item(a.in[I_WOUT], D, D, Wout, 64 * kb, 32 * nb, 32 * nb, scr, lane); continue; } r -= I_OUT;
        if (r < I_FFI) { const int kb = r / NB_FFI, nb = r % NB_FFI; const int n0 = 32 * nb; const int nn = n0 < HID ? n0 : n0 - HID; const int dst = 256 * (nn / 128) + (nn % 128) + (n0 < HID ? 0 : 128);
            transpose_item(a.in[I_WFFI], D, NFF, Wffi, 64 * kb, n0, dst, scr, lane); continue; } r -= I_FFI;
        { const int kb = r / 32, nb = r % 32; transpose_item(a.in[I_WFFO], HID, D, Wffo, 64 * kb, 32 * nb, 32 * nb, scr, lane); }
    }
    const int gt = vcu * NTHR + tid, NGT = G * NTHR;
    for (int i = gt; i < (PP - NIN) * D / 8; i += NGT) ((u32x4*)(Win + (size_t)NIN * D))[i] = (u32x4){0u, 0u, 0u, 0u};
    bf16* wup = (bf16*)(ws + WS_WUP); bf16* aup = (bf16*)(ws + WS_AUP); bf16* gup = (bf16*)(ws + WS_GUP);
    for (int i = gt; i < 512 * 64; i += NGT) { const int n = i >> 6, k = i & 63; wup[i] = (bf16)f2bf(a.in[I_WUP][k * 512 + n]); aup[i] = (bf16)f2bf(a.in[I_AUP][k * 512 + n]); }
    for (int i = gt; i < 512 * 160; i += NGT) { const int n = i / 160, k = i % 160; gup[i] = (bf16)f2bf(a.in[I_GUP][k * 512 + n]); }
}

template <int MODE>
__device__ __forceinline__ void ln_rows(const float* src, const float* g, const float* bvec, const float* mod, float* stats, float* fout, bf16* hout, int lane, int gw, int NGW) {
    for (int m = gw; m < M; m += NGW) {
        const f32x4* xr = (const f32x4*)(src + (size_t)m * D) + lane;
        f32x4 v[4]; float s = 0.f;
#pragma unroll
        for (int j = 0; j < 4; ++j) { v[j] = xr[64 * j]; s += (v[j].x + v[j].y) + (v[j].z + v[j].w); }
        const float mean = wave_sum(s) * (1.f / D); float s2 = 0.f;
#pragma unroll
        for (int j = 0; j < 4; ++j) { v[j] = v[j] - mean; s2 += (v[j].x * v[j].x + v[j].y * v[j].y) + (v[j].z * v[j].z + v[j].w * v[j].w); }
        const float rstd = 1.f / sqrtf(wave_sum(s2) * (1.f / D) + LN_EPS);
        if (MODE == 0 && lane == 0) { stats[2 * m] = mean; stats[2 * m + 1] = rstd; }
        const int b = m >> 11;
#pragma unroll
        for (int j = 0; j < 4; ++j) { const int c = 4 * (lane + 64 * j);
            const f32x4 y = v[j] * rstd * *(const f32x4*)(g + c) + *(const f32x4*)(bvec + c);
            if (MODE == 1 || MODE == 2) *(f32x4*)(fout + (size_t)m * D + c) = y;
            if (MODE == 0 || MODE == 1) { const float* mb = mod + b * 6144 + (MODE == 0 ? 0 : 3072);
                const f32x4 hv = y * (*(const f32x4*)(mb + 1024 + c) + 1.0f) + *(const f32x4*)(mb + c);
                *(u32x2*)(hout + (size_t)m * D + c) = pk4(hv); } }
    }
}

__device__ __forceinline__ void lora_prep(const Args& a, int lane, int wave, int vcu) {
    unsigned char* ws = a.ws;
    const bf16* p = (const bf16*)(ws + WS_P); const bf16* wup = (const bf16*)(ws + WS_WUP); const bf16* aup = (const bf16*)(ws + WS_AUP); const bf16* gup = (const bf16*)(ws + WS_GUP);
    _Float16* E = (_Float16*)(ws + WS_E); bf16* A = (bf16*)(ws + WS_A); bf16* Gt = (bf16*)(ws + WS_G);
    const float* mu = a.in[I_MU];
    const int fr = lane & 15, fq = lane >> 4;
    const int row = (vcu * NWAVES + wave) * 16 + fr;
    const bool hp = (row & (T - 1)) != 0;
    const bf16* cur = p + (size_t)row * PP + 1024 + 1536 + 8 * fq; const bf16* prv = hp ? cur - PP : cur;
    bf16x8 Bf[9];
#pragma unroll
    for (int s = 0; s < 9; ++s) {
        const int cofs = 32 * s;
        const u32x4 cu = *(const u32x4*)(cur + cofs), pu = *(const u32x4*)(prv + cofs);
        const f32x4 m0 = *(const f32x4*)(mu + 1536 + cofs + 8 * fq), m1 = *(const f32x4*)(mu + 1536 + cofs + 8 * fq + 4);
        float xs[8];
#pragma unroll
        for (int j = 0; j < 4; ++j) { const unsigned cw = cu[j], pw = hp ? pu[j] : 0u; const float c0 = bf_lo(cw), c1 = bf_hi(cw), p0 = bf_lo(pw), p1 = bf_hi(pw);
            const float mm0 = j < 2 ? m0[2 * j] : m1[2 * j - 4], mm1 = j < 2 ? m0[2 * j + 1] : m1[2 * j - 3];
            xs[2 * j] = c0 + (p0 - c0) * mm0; xs[2 * j + 1] = c1 + (p1 - c1) * mm1; }
#pragma unroll
        for (int j = 0; j < 8; ++j) { if (s < 2) xs[j] = 2.0f * sigmoidf_(2.0f * xs[j]) - 1.0f; else if (s >= 4) xs[j] = sigmoidf_(xs[j]); }
        u32x4 w; w.x = pk2(xs[0], xs[1]); w.y = pk2(xs[2], xs[3]); w.z = pk2(xs[4], xs[5]); w.w = pk2(xs[6], xs[7]);
        Bf[s] = __builtin_bit_cast(bf16x8, w);
    }
    const float* w0 = a.in[I_W0]; const float* a0 = a.in[I_A0];
    for (int ct = 0; ct < 32; ++ct) {
        const int ch = 16 * ct + fr;
        f32x4 aw = {0.f, 0.f, 0.f, 0.f}, aa = aw, ag = aw;
#pragma unroll
        for (int s = 0; s < 2; ++s) { const bf16x8 fw = *(const bf16x8*)(wup + ch * 64 + 32 * s + 8 * fq); aw = __builtin_amdgcn_mfma_f32_16x16x32_bf16(fw, Bf[s], aw, 0, 0, 0); }
#pragma unroll
        for (int s = 0; s < 2; ++s) { const bf16x8 fa = *(const bf16x8*)(aup + ch * 64 + 32 * s + 8 * fq); aa = __builtin_amdgcn_mfma_f32_16x16x32_bf16(fa, Bf[2 + s], aa, 0, 0, 0); }
#pragma unroll
        for (int s = 0; s < 5; ++s) { const bf16x8 fg = *(const bf16x8*)(gup + ch * 160 + 32 * s + 8 * fq); ag = __builtin_amdgcn_mfma_f32_16x16x32_bf16(fg, Bf[4 + s], ag, 0, 0, 0); }
        const int c0 = 16 * ct + 4 * fq;
        const f32x4 w04 = *(const f32x4*)(w0 + c0), a04 = *(const f32x4*)(a0 + c0);
        f32x4 ev, av;
#pragma unroll
        for (int e = 0; e < 4; ++e) { ev[e] = 0.6065306597126334f * sigmoidf_(w04[e] + aw[e]); av[e] = sigmoidf_(a04[e] + aa[e]); }
        const size_t o = (size_t)row * 512 + c0;
        *(f16x4*)(E + o) = __builtin_convertvector(ev, f16x4);
        *(u32x2*)(A + o) = pk4(av);
        *(u32x2*)(Gt + o) = pk4(ag);
    }
}

__device__ __forceinline__ int swz256(int row, int k) { return row * 256 + ((((k >> 3) ^ (row & 15))) << 4) + (k & 7) * 2; }
__device__ __forceinline__ void gmlp_unit(const Args& a, LAS unsigned char* lds, int tid, int lane, int wave, int unit) {
    unsigned char* ws = a.ws;
    const bf16* p = (const bf16*)(ws + WS_P); bf16* Y = (bf16*)(ws + WS_Y);
    const int rowB = unit * 128;
    LAS unsigned char* WL = lds; LAS unsigned char* VT = lds + 32768; LAS float* st = (LAS float*)(lds + 65536);
    {
        const int r = tid >> 2, part = tid & 3; const bf16* q = p + (size_t)(rowB + r) * PP + 512 + 128 * part;
        float s = 0.f, s2 = 0.f;
#pragma unroll
        for (int i = 0; i < 16; ++i) { const u32x4 w = *(const u32x4*)(q + 8 * i);
#pragma unroll
            for (int j = 0; j < 4; ++j) { const float x0 = bf_lo(w[j]), x1 = bf_hi(w[j]); s += x0 + x1; s2 += x0 * x0 + x1 * x1; } }
        s = reduce4(s); s2 = reduce4(s2);
        const float mean = s * (1.f / 512.f), var = fmaxf(s2 * (1.f / 512.f) - mean * mean, 0.f);
        if (part == 0) { st[2 * r] = mean; st[2 * r + 1] = 1.f / sqrtf(var + LN_EPS); }
    }
    __syncthreads();
    const int fr = lane & 15, fq = lane >> 4;
    for (int g = 0; g < 4; ++g) {
        const float* Wg = a.in[I_WS] + (size_t)g * 128 * 128;
#pragma unroll
        for (int i = 0; i < 4; ++i) { const int idx = tid + i * NTHR, t = idx >> 4, ck = idx & 15;
            const f32x4 w0 = *(const f32x4*)(Wg + t * 128 + 8 * ck), w1 = *(const f32x4*)(Wg + t * 128 + 8 * ck + 4);
            float x[8] = {w0.x, w0.y, w0.z, w0.w, w1.x, w1.y, w1.z, w1.w};
#pragma unroll
            for (int j = 0; j < 8; ++j) if (8 * ck + j > t) x[j] = 0.f;
            u32x4 o; o.x = pk2(x[0], x[1]); o.y = pk2(x[2], x[3]); o.z = pk2(x[4], x[5]); o.w = pk2(x[6], x[7]);
            *(LAS u32x4*)(WL + swz256(t, 8 * ck)) = o; }
#pragma unroll
        for (int i = 0; i < 4; ++i) { const int idx = tid + i * NTHR, s = idx >> 4, dc = idx & 15;
            const u32x4 w = *(const u32x4*)(p + (size_t)(rowB + s) * PP + 512 + 128 * g + 8 * dc);
            const float mean = st[2 * s], rstd = st[2 * s + 1];
            const f32x4 g0 = *(const f32x4*)(a.in[I_SGG] + 128 * g + 8 * dc), g1 = *(const f32x4*)(a.in[I_SGG] + 128 * g + 8 * dc + 4);
            const f32x4 b0 = *(const f32x4*)(a.in[I_SGB] + 128 * g + 8 * dc), b1 = *(const f32x4*)(a.in[I_SGB] + 128 * g + 8 * dc + 4);
#pragma unroll
            for (int j = 0; j < 8; ++j) { const float x = (j & 1) ? bf_hi(w[j >> 1]) : bf_lo(w[j >> 1]); const float gg = j < 4 ? g0[j] : g1[j - 4], bb = j < 4 ? b0[j] : b1[j - 4];
                const float v = (x - mean) * rstd * gg + bb;
                *(LAS unsigned short*)(VT + swz256(8 * dc + j, s)) = (unsigned short)f2bf(v); } }
        __syncthreads();
        f32x4 acc[8];
#pragma unroll
        for (int dt = 0; dt < 8; ++dt) acc[dt] = (f32x4){0.f, 0.f, 0.f, 0.f};
        const int nks = ((16 * wave + 15) >> 5) + 1;
        for (int ks = 0; ks < nks; ++ks) {
            const bf16x8 bfrag = *(const LAS bf16x8*)(WL + swz256(16 * wave + fr, 32 * ks + 8 * fq));
#pragma unroll
            for (int dt = 0; dt < 8; ++dt) { const bf16x8 afrag = *(const LAS bf16x8*)(VT + swz256(16 * dt + fr, 32 * ks + 8 * fq));
                acc[dt] = __builtin_amdgcn_mfma_f32_16x16x32_bf16(afrag, bfrag, acc[dt], 0, 0, 0); }
        }
        const int t = 16 * wave + fr; const float bs = a.in[I_BS][g * 128 + t];
        const bf16* up = p + (size_t)(rowB + t) * PP + 128 * g + 4 * fq; bf16* yp = Y + (size_t)(rowB + t) * D + 128 * g + 4 * fq;
#pragma unroll
        for (int dt = 0; dt < 8; ++dt) { const f32x4 uv = unpk4(*(const u32x2*)(up + 16 * dt)); *(u32x2*)(yp + 16 * dt) = pk4(uv * (acc[dt] + bs)); }
        __syncthreads();
    }
}

struct ScanRaw { u32x2 rc, rp, kc, kp, vc, vp, e, a; };
__device__ __forceinline__ void scan_load(ScanRaw& R, const bf16* p, const _Float16* E, const bf16* A, size_t row, bool hp, int colh) {
    const bf16* cur = p + row * PP + 1024 + colh; const bf16* prv = hp ? cur - PP : cur;
    R.rc = *(const u32x2*)(cur); R.kc = *(const u32x2*)(cur + 512); R.vc = *(const u32x2*)(cur + 1024);
    R.rp = *(const u32x2*)(prv); R.kp = *(const u32x2*)(prv + 512); R.vp = *(const u32x2*)(prv + 1024);
    if (!hp) { R.rp = (u32x2){0u, 0u}; R.kp = R.rp; R.vp = R.rp; }
    R.e = *(const u32x2*)(E + row * 512 + colh); R.a = *(const u32x2*)(A + row * 512 + colh);
}
constexpr int SC_CT = 32, SC_BUF = 5 * SC_CT * 64 + SC_CT * 32;
__device__ __forceinline__ void scan_phase(const Args& a, LAS unsigned char* lds, int tid, int lane, int wave, int vcu) {
    unsigned char* ws = a.ws;
    const bf16* p = (const bf16*)(ws + WS_P); const _Float16* E = (const _Float16*)(ws + WS_E); const bf16* A = (const bf16*)(ws + WS_A);
    float* yraw = (float*)(ws + WS_YRAW); float* rkout = (float*)(ws + WS_RK);
    const int bh = vcu >> 1, half = vcu & 1, b = bh >> 3, h = bh & 7;
    const size_t row0 = (size_t)b * T;
    const int tp = tid >> 4, cs = tid & 15, colh = 64 * h + 4 * cs;
    LAS float* bufs = (LAS float*)lds; LAS float* Ybuf = (LAS float*)(lds + 2 * SC_BUF * 4);
    const float* mu = a.in[I_MU];
    const f32x4 mur = *(const f32x4*)(mu + colh), muk = *(const f32x4*)(mu + 512 + colh), muv = *(const f32x4*)(mu + 1024 + colh);
    const f32x4 kkc = *(const f32x4*)(a.in[I_KK] + colh), kac = *(const f32x4*)(a.in[I_KA] + colh), rkc = *(const f32x4*)(a.in[I_RK] + colh);
    ScanRaw R;
    auto prep = [&](int c) {
        LAS float* buf = bufs + (c & 1) * SC_BUF;
        const f32x4 rc = unpk4(R.rc), rp = unpk4(R.rp), kc = unpk4(R.kc), kp_ = unpk4(R.kp), vc = unpk4(R.vc), vp = unpk4(R.vp);
        const f32x4 rs = rc + (rp - rc) * mur, ks = kc + (kp_ - kc) * muk, vs = vc + (vp - vc) * muv;
        const f32x4 ev = __builtin_convertvector(__builtin_bit_cast(f16x4, R.e), f32x4), av = unpk4(R.a);
        f32x4 kk = ks * kkc;
        float n2 = (kk.x * kk.x + kk.y * kk.y) + (kk.z * kk.z + kk.w * kk.w); n2 = reduce16(n2);
        const float inv = 1.0f / fmaxf(sqrtf(n2), 1e-12f);
        kk = kk * inv;
        const f32x4 kpr = ks * ((av - 1.0f) * kac + 1.0f);
        const f32x4 rkp = rs * kpr * rkc; float rk = (rkp.x + rkp.y) + (rkp.z + rkp.w); rk = reduce16(rk);
        f32x4 wv;
#pragma unroll
        for (int e = 0; e < 4; ++e) wv[e] = __builtin_amdgcn_exp2f(-1.4426950408889634f * ev[e]);
        *(LAS f32x4*)(buf + tp * 64 + 4 * cs) = wv;
        *(LAS f32x4*)(buf + 2048 + tp * 64 + 4 * cs) = -kk;
        *(LAS f32x4*)(buf + 4096 + tp * 64 + 4 * cs) = kk * av;
        *(LAS f32x4*)(buf + 6144 + tp * 64 + 4 * cs) = kpr;
        *(LAS f32x4*)(buf + 8192 + tp * 64 + 4 * cs) = rs;
        if ((cs >> 3) == half) *(LAS f32x4*)(buf + 10240 + tp * 32 + 4 * (cs & 7)) = vs;
        if (half == 0 && cs == 0) rkout[(row0 + (size_t)c * SC_CT + tp) * 8 + h] = rk;
    };
    scan_load(R, p, E, A, row0 + tp, tp != 0, colh);
    prep(0);
    __syncthreads();
    float S0 = 0.f, S1 = 0.f, S2 = 0.f, S3 = 0.f;
    constexpr int NCH = T / SC_CT;
    for (int c = 0; c < NCH; ++c) {
        if (c + 1 < NCH) scan_load(R, p, E, A, row0 + (size_t)(c + 1) * SC_CT + tp, true, colh);
        const LAS float* buf = bufs + (c & 1) * SC_BUF; LAS float* Yb = Ybuf + (c & 1) * (SC_CT * 32);
#pragma unroll 4
        for (int t = 0; t < SC_CT; ++t) {
            const f32x4 wv = *(const LAS f32x4*)(buf + t * 64 + 4 * cs), av = *(const LAS f32x4*)(buf + 2048 + t * 64 + 4 * cs), bv = *(const LAS f32x4*)(buf + 4096 + t * 64 + 4 * cs);
            const f32x4 kv = *(const LAS f32x4*)(buf + 6144 + t * 64 + 4 * cs), rv = *(const LAS f32x4*)(buf + 8192 + t * 64 + 4 * cs);
            const float vi = buf[10240 + t * 32 + tp];
            float sa = (S0 * av.x + S1 * av.y) + (S2 * av.z + S3 * av.w); sa = reduce16(sa);
            S0 = S0 * wv.x + (sa * bv.x + vi * kv.x); S1 = S1 * wv.y + (sa * bv.y + vi * kv.y); S2 = S2 * wv.z + (sa * bv.z + vi * kv.z); S3 = S3 * wv.w + (sa * bv.w + vi * kv.w);
            float y = (S0 * rv.x + S1 * rv.y) + (S2 * rv.z + S3 * rv.w); y = reduce16(y);
            if (cs == 0) Yb[t * 32 + tp] = y;
        }
        if (c + 1 < NCH) prep(c + 1);
        __syncthreads();
        { const f32x2 yv = *(const LAS f32x2*)(Yb + tp * 32 + 2 * cs);
          *(f32x2*)(yraw + (row0 + (size_t)c * SC_CT + tp) * 512 + 64 * h + 32 * half + 2 * cs) = yv; }
    }
}

__device__ __forceinline__ void rwkv_post(const Args& a, int tid, int vcu) {
    unsigned char* ws = a.ws;
    const bf16* p = (const bf16*)(ws + WS_P); const float* yraw = (const float*)(ws + WS_YRAW); const float* rk = (const float*)(ws + WS_RK); const bf16* Gt = (const bf16*)(ws + WS_G);
    bf16* Y = (bf16*)(ws + WS_Y);
    const int cs = tid & 15; const float* mu = a.in[I_MU];
    for (int it = 0; it < 32; ++it) {
        const int pair = it * 32 + (tid >> 4), row = vcu * 128 + (pair >> 3), h = pair & 7, c = 64 * h + 4 * cs;
        const f32x4 y4 = *(const f32x4*)(yraw + (size_t)row * 512 + c);
        float s = (y4.x + y4.y) + (y4.z + y4.w); s = reduce16(s); const float mean = s * (1.f / 64.f);
        const f32x4 d = y4 - mean; float q = (d.x * d.x + d.y * d.y) + (d.z * d.z + d.w * d.w); q = reduce16(q);
        const float rstd = 1.f / sqrtf(q * (1.f / 64.f) + GN_EPS);
        const f32x4 yn = d * rstd * *(const f32x4*)(a.in[I_LXG] + c) + *(const f32x4*)(a.in[I_LXB] + c);
        const bool hp = (row & (T - 1)) != 0;
        const bf16* cur = p + (size_t)row * PP + 2048 + c; const bf16* prv = hp ? cur - PP : cur;
        const f32x4 vc = unpk4(*(const u32x2*)cur); f32x4 vp = unpk4(*(const u32x2*)prv); if (!hp) vp = (f32x4){0.f, 0.f, 0.f, 0.f};
        const f32x4 vs = vc + (vp - vc) * *(const f32x4*)(mu + 1024 + c);
        const float rkv = rk[(size_t)row * 8 + h];
        const f32x4 g4 = unpk4(*(const u32x2*)(Gt + (size_t)row * 512 + c));
        *(u32x2*)(Y + (size_t)row * D + 512 + c) = pk4((yn + vs * rkv) * g4);
    }
}

__global__ void __launch_bounds__(NTHR, 2) fwd_kernel(Args args) {
    extern __shared__ __attribute__((aligned(16))) unsigned char lds_raw[];
    LAS unsigned char* lds = (LAS unsigned char*)lds_raw;
    const int tid = threadIdx.x, lane = tid & 63, wave = __builtin_amdgcn_readfirstlane(tid >> 6);
    const int G = gridDim.x, bx = blockIdx.x, vcu = (G % 8 == 0) ? (bx % 8) * (G / 8) + bx / 8 : bx;
    const int gw = vcu * NWAVES + wave, NGW = G * NWAVES;
    unsigned char* ws = args.ws;
    volatile LAS unsigned* bst = (volatile LAS unsigned*)(lds + LDS_BYTES - 16);
    if (tid < 4) bst[tid] = 0u;
    __syncthreads();
    XcdBarrier bar = xcd_barrier_post((unsigned*)ws, bst);
    const int lo = args.ph_lo, hi = args.ph_hi;
#define IN(k) (lo <= (k) && (k) < hi)
#define SEAM(k) do { if (IN(k) && IN((k) + 1)) xcd_barrier(bar); } while (0)
    float* mod = (float*)(ws + WS_MOD); float* stats = (float*)(ws + WS_STATS);
    bf16* Hb = (bf16*)(ws + WS_H); bf16* Pb = (bf16*)(ws + WS_P); bf16* Yb = (bf16*)(ws + WS_Y); bf16* HIDb = (bf16*)(ws + WS_HID); float* X1 = (float*)(ws + WS_X1);

#define REP(k) for (int rep_ = 0; rep_ < (((DUP_MASK) >> (k)) & 1) + 1; ++rep_)
    if (IN(0)) REP(0) { p0_prologue(args, lds, tid, lane, wave, vcu, G); __syncthreads(); } SEAM(0);
    if (IN(1)) REP(1) { ln_rows<0>(args.in[I_X], args.in[I_EG], args.in[I_EB], mod, stats, nullptr, Hb, lane, gw, NGW); } SEAM(1);
    if (IN(2)) REP(2) {
        pg8::Gemm g{Hb, (const bf16*)(ws + WS_WIN), M, PP, D}; pg8::StaticOrder S; S.init(M, PP, G, bx);
        pg8::EpiP E{Pb};
        pg8::gemm_phase<pg8::EpiP, pg8::StaticOrder, true, true>(lds, g, S, E);
    } SEAM(2);
    if (IN(3)) REP(3) { lora_prep(args, lane, wave, vcu); gmlp_unit(args, lds, tid, lane, wave, vcu); } SEAM(3);
    if (IN(4)) REP(4) { scan_phase(args, lds, tid, lane, wave, vcu); __syncthreads(); } SEAM(4);
    if (IN(5)) REP(5) { rwkv_post(args, tid, vcu); } SEAM(5);
    if (IN(6)) REP(6) {
        pg8::Gemm g{Yb, (const bf16*)(ws + WS_WOUT), M, D, D}; pg8::StaticOrder S; S.init(M, D, G, bx);
        pg8::EpiZ1 E{args.in[I_X], stats, args.in[I_EG], args.in[I_EB], mod, args.out};
        pg8::gemm_phase<pg8::EpiZ1, pg8::StaticOrder, true, true>(lds, g, S, E);
    } SEAM(6);
    if (IN(7)) REP(7) { ln_rows<1>(args.out, args.in[I_L1G], args.in[I_L1B], mod, nullptr, X1, Hb, lane, gw, NGW); } SEAM(7);
    if (IN(8)) REP(8) {
        pg8::Gemm g{Hb, (const bf16*)(ws + WS_WFFI), M, NFF, D}; pg8::StaticOrder S; S.init(M, NFF, G, bx);
        pg8::EpiHid E{HIDb};
        pg8::gemm_phase<pg8::EpiHid, pg8::StaticOrder, true, true>(lds, g, S, E);
    } SEAM(8);
    if (IN(9)) REP(9) {
        pg8::Gemm g{HIDb, (const bf16*)(ws + WS_WFFO), M, D, HID}; pg8::StaticOrder S; S.init(M, D, G, bx);
        pg8::EpiZ2 E{X1, mod, args.out};
        pg8::gemm_phase<pg8::EpiZ2, pg8::StaticOrder, true, true>(lds, g, S, E);
    } SEAM(9);
    if (IN(10)) { ln_rows<2>(args.out, args.in[I_L2G], args.in[I_L2B], mod, nullptr, args.out, nullptr, lane, gw, NGW); }
#undef REP
#undef IN
#undef SEAM
}

extern "C" void kernel_launch(void* const* d_in, const int* in_sizes, int n_in, void* d_out, int out_size, void* d_ws, size_t ws_size, hipStream_t stream) {
    static int grid = 0;
    if (grid == 0) {
        if (n_in != N_IN || in_sizes[0] != M * D || out_size != M * D || ws_size < WS_END) { fprintf(stderr, "kernel_launch: unexpected shapes (n_in %d, in0 %d, out %d, ws %zu)\n", n_in, n_in > 0 ? in_sizes[0] : -1, out_size, ws_size); grid = -1; return; }
        int dev = 0, cus = 0, per_cu = 0;
        (void)hipGetDevice(&dev); (void)hipDeviceGetAttribute(&cus, hipDeviceAttributeMultiprocessorCount, dev);
        (void)hipFuncSetAttribute((const void*)fwd_kernel, hipFuncAttributeMaxDynamicSharedMemorySize, LDS_BYTES);
        (void)hipOccupancyMaxActiveBlocksPerMultiprocessor(&per_cu, (const void*)fwd_kernel, NTHR, LDS_BYTES);
        if (per_cu < 1) { fprintf(stderr, "kernel_launch: occupancy query says %d blocks per CU\n", per_cu); per_cu = 1; }
        (void)hipGetLastError();
        grid = cus;
        if (grid != 256) fprintf(stderr, "kernel_launch: %d CUs; this kernel is written for 256\n", grid);
    }
    if (grid < 0) return;
    Args a{};
    for (int i = 0; i < N_IN; ++i) a.in[i] = (const float*)d_in[i];
    a.out = (float*)d_out; a.ws = (unsigned char*)d_ws; a.ph_lo = 0; a.ph_hi = 11;
    (void)hipMemsetAsync(d_ws, 0, XCD_BAR_WORDS * 4, stream);
    void* kargs[] = {&a};
    hipError_t e = hipLaunchCooperativeKernel((const void*)fwd_kernel, dim3(grid), dim3(NTHR), kargs, LDS_BYTES, stream);
    if (e != hipSuccess) fprintf(stderr, "cooperative launch failed: %s (grid %d)\n", hipGetErrorString(e), grid);
}
```
